# Optimizing an MI355X kernel written in HIP

```python
import jax, jax.numpy as jnp
from jax import lax
import numpy as np

D_MODEL = 1024
BATCH = 2
SEQ = 8192
DEPTH = 2
DEC_BATCH = 32
DEC_SEQ = 16
PAST_LEN = 2048

CHUNK = 64
HEAD_DIM = 64
MIX_HEADS = D_MODEL // HEAD_DIM
A_GROUPS = MIX_HEADS // 4
C_HEADS = (MIX_HEADS - A_GROUPS) // 2
B_HEADS = MIX_HEADS - A_GROUPS - C_HEADS
B_KV_HEADS = 1
A_WIDTH = A_GROUPS * HEAD_DIM
B_WIDTH = B_HEADS * HEAD_DIM
B_KV_WIDTH = B_KV_HEADS * HEAD_DIM
C_WIDTH = C_HEADS * HEAD_DIM
D_MIX = A_WIDTH + B_WIDTH + C_WIDTH
A_CHUNK = 128
IDX_HEADS = 8
IDX_DIM = 32
TOPK_MAX = 256
Q_BLOCK = 128
ROPE_BASE = 10000.0
D_FF = 2816
CONV_W = 3
LN_EPS = 1e-5
ALPHA = (2 * DEPTH) ** 0.25
BETA = (8 * DEPTH) ** -0.25
PROJ_SIZES = (A_WIDTH, A_WIDTH, B_WIDTH, B_KV_WIDTH, B_KV_WIDTH, IDX_HEADS * IDX_DIM, IDX_DIM,
              IDX_HEADS, C_WIDTH, C_WIDTH, C_WIDTH, C_WIDTH)
PROJ_SPLITS = tuple(int(s) for s in np.cumsum(PROJ_SIZES)[:-1])
D_PROJ = int(sum(PROJ_SIZES))

kernel_name = 'hybrid_streaming_encoder_step'

F32 = jnp.float32


def layer_norm(x, g, b):
    xf = x.astype(F32)
    mu = xf.mean(-1, keepdims=True)
    var = jnp.square(xf - mu).mean(-1, keepdims=True)
    return ((xf - mu) * lax.rsqrt(var + LN_EPS) * g + b).astype(x.dtype)


def head_norm(y, g):
    yf = y.astype(F32)
    mu = yf.mean(-1, keepdims=True)
    var = jnp.square(yf - mu).mean(-1, keepdims=True)
    return (yf - mu) * lax.rsqrt(var + LN_EPS) * g.reshape(C_HEADS, HEAD_DIM)


def rotary(x, pos):
    half = HEAD_DIM // 2
    freqs = ROPE_BASE ** (-jnp.arange(half, dtype=F32) / half)
    ang = pos.astype(F32)[:, None] * freqs
    cos, sin = jnp.cos(ang)[None, :, None, :], jnp.sin(ang)[None, :, None, :]
    xf = x.astype(F32)
    x1, x2 = xf[..., :half], xf[..., half:]
    return jnp.concatenate([x1 * cos - x2 * sin, x1 * sin + x2 * cos], -1).astype(x.dtype)


def mixer_a(u_raw, v_raw, ln_g, ln_b, ws, bs, chunk_len):
    u = jax.nn.gelu(u_raw)
    v = jax.nn.gelu(v_raw)
    bn, t, _ = v.shape
    n = t // chunk_len
    vn = layer_norm(v.reshape(bn, t, A_GROUPS, HEAD_DIM), ln_g.reshape(A_GROUPS, HEAD_DIM),
                    ln_b.reshape(A_GROUPS, HEAD_DIM))
    vc = vn.reshape(bn, n, chunk_len, A_GROUPS, HEAD_DIM)
    w = ws[:, :chunk_len, :chunk_len] * jnp.tril(jnp.ones((chunk_len, chunk_len), ws.dtype))
    s = jnp.einsum('gij,bnjgc->bnigc', w, vc) + bs[:, :chunk_len].T[None, None, :, :, None]
    return u * s.reshape(bn, t, A_WIDTH), vn.reshape(bn, t, A_WIDTH)


def dsa_attend(q, qi, wi, k, v, ki, limit, k_sel):
    bn, t, _ = q.shape
    l = k.shape[1]
    qi = qi.reshape(bn, t, IDX_HEADS, IDX_DIM)
    rel = jax.nn.relu(jnp.einsum('bthd,bsd->bths', qi, ki).astype(F32) * IDX_DIM ** -0.5)
    score = jnp.einsum('bths,bth->bts', rel, wi.astype(F32)) * IDX_HEADS ** -0.5
    adm = jnp.arange(l)[None, :] < limit[:, None]
    score = jnp.where(adm[None], score, -jnp.inf)
    _, idx = lax.top_k(score, k_sel)
    valid = idx < limit[None, :, None]
    gather = jax.vmap(lambda a, i: a[i])
    ks = gather(k, idx).reshape(bn, t, k_sel, B_KV_HEADS, HEAD_DIM)
    vs = gather(v, idx).reshape(bn, t, k_sel, B_KV_HEADS, HEAD_DIM)
    qh = q.reshape(bn, t, B_KV_HEADS, B_HEADS // B_KV_HEADS, HEAD_DIM)
    logits = jnp.einsum('btngd,btknd->btngk', qh, ks).astype(F32) * HEAD_DIM ** -0.5
    logits = jnp.where(valid[:, :, None, None, :], logits, -jnp.inf)
    p = jax.nn.softmax(logits, axis=-1).astype(v.dtype)
    o = jnp.einsum('btngk,btknd->btngd', p, vs)
    return o.reshape(bn, t, B_WIDTH)


def dsa_prompt(q, qi, wi, k, v, ki):
    bn, s, _ = q.shape
    nb = s // Q_BLOCK
    k_sel = min(TOPK_MAX, s // 4)

    def blocks(a):
        return a.reshape(bn, nb, Q_BLOCK, a.shape[-1]).swapaxes(0, 1)

    pos = jnp.arange(s).reshape(nb, Q_BLOCK)
    limit = (pos // CHUNK + 1) * CHUNK

    def one(args):
        qb, qib, wib, lim = args
        return dsa_attend(qb, qib, wib, k, v, ki, lim, k_sel)

    o = lax.map(one, (blocks(q), blocks(qi), blocks(wi), limit))
    return o.swapaxes(0, 1).reshape(bn, s, B_WIDTH)


def retention_terms(q, k, v, log_g):
    c = q.shape[2]
    i = jnp.arange(c, dtype=F32)
    diff = i[:, None] - i[None, :]
    decay = jnp.where(diff >= 0, jnp.exp(jnp.maximum(diff, 0.0)[None] * log_g[:, None, None]), 0.0)
    s = jnp.einsum('bnihd,bnjhd->bnhij', q, k) * decay
    intra = jnp.einsum('bnhij,bnjhe->bnihe', s, v)
    kv = jnp.einsum('bnjhd,hj,bnjhe->bnhde', k, jnp.exp((c - 1 - i)[None] * log_g[:, None]), v)
    q_decay = jnp.exp((i + 1)[None] * log_g[:, None])
    chunk_decay = jnp.exp(c * log_g)
    return intra, kv, q_decay, chunk_decay


def mixer_c(qr, kr, vr, gr, gn_g, pos, r0, chunk_len):
    bn, t, _ = qr.shape
    n = t // chunk_len
    log_g = jnp.log(1.0 - 2.0 ** (-5.0 - jnp.arange(C_HEADS, dtype=F32)))
    q = rotary(qr.reshape(bn, t, C_HEADS, HEAD_DIM), pos)
    k = rotary(kr.reshape(bn, t, C_HEADS, HEAD_DIM), pos) * HEAD_DIM ** -0.5
    sh = (bn, n, chunk_len, C_HEADS, HEAD_DIM)
    q = q.reshape(sh)
    intra, kv, q_decay, chunk_decay = retention_terms(q, k.reshape(sh), vr.reshape(sh), log_g)

    def step(r, kv_n):
        return chunk_decay[None, :, None, None] * r + kv_n, r

    r_final, r_prev = lax.scan(step, r0.astype(F32), kv.swapaxes(0, 1).astype(F32))
    cross = jnp.einsum('bnihd,nbhde,hi->bnihe', q, r_prev, q_decay)
    y = head_norm((intra + cross).reshape(bn, t, C_HEADS, HEAD_DIM), gn_g)
    return jax.nn.silu(gr) * y.reshape(bn, t, C_WIDTH), r_final


def conv_ffn(x, conv_prev, w_gate, w_up, conv_w, conv_b, w_down):
    t = x.shape[1]
    hg = x @ w_gate
    hu = x @ w_up
    ext = jnp.concatenate([conv_prev.astype(hg.dtype), hg], axis=1)
    conv = conv_b + sum(conv_w[j] * ext[:, j:j + t] for j in range(CONV_W))
    return (jax.nn.gelu(conv) * hu) @ w_down, ext[:, t:]


def finish(x, mix, w_out, ln1_g, ln1_b, conv_prev, w_gate, w_up, conv_w, conv_b, w_down, ln2_g, ln2_b):
    x = layer_norm(ALPHA * x + (mix @ w_out).astype(x.dtype), ln1_g, ln1_b)
    f, conv_state = conv_ffn(x, conv_prev, w_gate, w_up, conv_w, conv_b, w_down)
    x = layer_norm(ALPHA * x + f.astype(x.dtype), ln2_g, ln2_b)
    return x, conv_state


def setup_inputs(seed: int = 0) -> dict:
    key = jax.random.key(seed)
    ks = jax.random.split(key, 24)

    def nrm(k, shape, scale):
        return jax.random.normal(k, shape, F32) * scale

    return {
        'x_prompt': nrm(ks[0], (BATCH, SEQ, D_MODEL), 1.0),
        'x_sample': nrm(ks[1], (DEC_BATCH, DEC_SEQ, D_MODEL), 1.0),
        'cache_b_k': nrm(ks[2], (DEPTH, DEC_BATCH, PAST_LEN, B_KV_WIDTH), 1.0),
        'cache_b_v': nrm(ks[3], (DEPTH, DEC_BATCH, PAST_LEN, B_KV_WIDTH), 1.0),
        'cache_b_kidx': nrm(ks[4], (DEPTH, DEC_BATCH, PAST_LEN, IDX_DIM), 1.0),
        'state_ret': nrm(ks[5], (DEPTH, DEC_BATCH, C_HEADS, HEAD_DIM, HEAD_DIM), 0.5),
        'state_ffn_conv': nrm(ks[6], (DEPTH, DEC_BATCH, CONV_W - 1, D_FF), 1.0),
        'w_in': nrm(ks[7], (DEPTH, D_MODEL, D_PROJ), D_MODEL ** -0.5),
        'a_ln_g': 1.0 + nrm(ks[8], (DEPTH, A_WIDTH), 0.01),
        'a_ln_b': nrm(ks[9], (DEPTH, A_WIDTH), 0.01),
        'a_ws': nrm(ks[10], (DEPTH, A_GROUPS, A_CHUNK, A_CHUNK), A_CHUNK ** -0.5),
        'a_bs': 1.0 + nrm(ks[11], (DEPTH, A_GROUPS, A_CHUNK), 0.01),
        'c_gn_g': 1.0 + nrm(ks[12], (DEPTH, C_WIDTH), 0.01),
        'w_out': nrm(ks[13], (DEPTH, D_MIX, D_MODEL), BETA * D_MIX ** -0.5),
        'ln1_g': 1.0 + nrm(ks[14], (DEPTH, D_MODEL), 0.01),
        'ln1_b': nrm(ks[15], (DEPTH, D_MODEL), 0.01),
        'w_gate': nrm(ks[16], (DEPTH, D_MODEL, D_FF), D_MODEL ** -0.5),
        'w_up': nrm(ks[17], (DEPTH, D_MODEL, D_FF), D_MODEL ** -0.5),
        'conv_w': nrm(ks[18], (DEPTH, CONV_W, D_FF), CONV_W ** -0.5),
        'conv_b': nrm(ks[19], (DEPTH, D_FF), 0.01),
        'w_down': nrm(ks[20], (DEPTH, D_FF, D_MODEL), BETA * D_FF ** -0.5),
        'ln2_g': 1.0 + nrm(ks[21], (DEPTH, D_MODEL), 0.01),
        'ln2_b': nrm(ks[22], (DEPTH, D_MODEL), 0.01),
    }


def reference(x_prompt, x_sample, cache_b_k, cache_b_v, cache_b_kidx, state_ret, state_ffn_conv,
              w_in, a_ln_g, a_ln_b, a_ws, a_bs, c_gn_g, w_out, ln1_g, ln1_b,
              w_gate, w_up, conv_w, conv_b, w_down, ln2_g, ln2_b):
    bp, s, _ = x_prompt.shape
    bs_, t, _ = x_sample.shape
    past = cache_b_k.shape[2]
    l_keys = past + t
    k_sel_s = min(TOPK_MAX, l_keys // 4)
    pos_p = jnp.arange(s)
    pos_s = past + jnp.arange(t)
    xp, xs = x_prompt, x_sample
    kp, vp, kip, rp, cp = [], [], [], [], []
    ks_, vs_, kis, rs, cs, avs = [], [], [], [], [], []
    for l in range(DEPTH):
        ua, va, qb, kb, vb, qib, kib, wib, qc, kc, vc, gc = jnp.split(xp @ w_in[l], PROJ_SPLITS, axis=-1)
        oa, _ = mixer_a(ua, va, a_ln_g[l], a_ln_b[l], a_ws[l], a_bs[l], A_CHUNK)
        ob = dsa_prompt(qb, qib, wib, kb, vb, kib)
        oc, r_p = mixer_c(qc, kc, vc, gc, c_gn_g[l], pos_p,
                          jnp.zeros((bp, C_HEADS, HEAD_DIM, HEAD_DIM), F32), CHUNK)
        mix = jnp.concatenate([oa, ob.astype(oa.dtype), oc.astype(oa.dtype)], axis=-1)
        xp, c_p = finish(xp, mix, w_out[l], ln1_g[l], ln1_b[l],
                         jnp.zeros((bp, CONV_W - 1, D_FF), xp.dtype),
                         w_gate[l], w_up[l], conv_w[l], conv_b[l], w_down[l], ln2_g[l], ln2_b[l])
        kp.append(kb); vp.append(vb); kip.append(kib); rp.append(r_p); cp.append(c_p)
        ua, va, qb, kb, vb, qib, kib, wib, qc, kc, vc, gc = jnp.split(xs @ w_in[l], PROJ_SPLITS, axis=-1)
        oa, av = mixer_a(ua, va, a_ln_g[l], a_ln_b[l], a_ws[l], a_bs[l], t)
        k_full = jnp.concatenate([cache_b_k[l].astype(kb.dtype), kb], axis=1)
        v_full = jnp.concatenate([cache_b_v[l].astype(vb.dtype), vb], axis=1)
        ki_full = jnp.concatenate([cache_b_kidx[l].astype(kib.dtype), kib], axis=1)
        ob = dsa_attend(qb, qib, wib, k_full, v_full, ki_full,
                        jnp.full((t,), l_keys, jnp.int32), k_sel_s)
        oc, r_s = mixer_c(qc, kc, vc, gc, c_gn_g[l], pos_s, state_ret[l], t)
        mix = jnp.concatenate([oa, ob.astype(oa.dtype), oc.astype(oa.dtype)], axis=-1)
        xs, c_s = finish(xs, mix, w_out[l], ln1_g[l], ln1_b[l], state_ffn_conv[l],
                         w_gate[l], w_up[l], conv_w[l], conv_b[l], w_down[l], ln2_g[l], ln2_b[l])
        ks_.append(kb); vs_.append(vb); kis.append(kib); rs.append(r_s); cs.append(c_s); avs.append(av)
    return (xp, xs, jnp.stack(kp), jnp.stack(vp), jnp.stack(kip), jnp.stack(rp), jnp.stack(cp),
            jnp.stack(ks_), jnp.stack(vs_), jnp.stack(kis), jnp.stack(rs), jnp.stack(cs), jnp.stack(avs))
```

```cpp
#include <hip/hip_runtime.h>
#include <hip/hip_cooperative_groups.h>
#include <cstdio>
namespace cg = cooperative_groups;

#ifndef MULTI
#define MULTI 0
#endif
#ifndef PROBE_MASK
#define PROBE_MASK 0
#endif

typedef unsigned short u16;
typedef unsigned int u32;
typedef __attribute__((ext_vector_type(8))) short bf16x8;
typedef __attribute__((ext_vector_type(4))) float f32x4;
typedef __attribute__((ext_vector_type(16))) float f32x16;

constexpr int NPR = 16384, NSR = 512, NR = 16896;
constexpr int DM = 1024, DPJ = 2856, DPJP = 2944, DFF = 2816;
constexpr int C_UA = 0, C_VA = 256, C_QB = 512, C_KB = 896, C_VB = 960, C_QI = 1024, C_KI = 1280,
              C_WI = 1312, C_QC = 1320, C_KC = 1704, C_VC = 2088, C_GC = 2472;
constexpr float ALPHA = 1.4142135623730951f;

constexpr size_t OFF_Y   = 0;
constexpr size_t OFF_KP  = (size_t)NR * DM;
constexpr size_t OFF_VP  = OFF_KP + 2ull * 2 * 8192 * 64;
constexpr size_t OFF_KIP = OFF_VP + 2ull * 2 * 8192 * 64;
constexpr size_t OFF_RP  = OFF_KIP + 2ull * 2 * 8192 * 32;
constexpr size_t OFF_CP  = OFF_RP + 2ull * 2 * 6 * 4096;
constexpr size_t OFF_KS  = OFF_CP + 2ull * 2 * 2 * DFF;
constexpr size_t OFF_VS  = OFF_KS + 2ull * 32 * 16 * 64;
constexpr size_t OFF_KIS = OFF_VS + 2ull * 32 * 16 * 64;
constexpr size_t OFF_RS  = OFF_KIS + 2ull * 32 * 16 * 32;
constexpr size_t OFF_CS  = OFF_RS + 2ull * 32 * 6 * 4096;
constexpr size_t OFF_AV  = OFF_CS + 2ull * 32 * 2 * DFF;

struct P {
  const float *x_prompt, *x_sample, *cache_k, *cache_v, *cache_ki, *state_ret, *state_conv;
  const float *w_in, *a_ln_g, *a_ln_b, *a_ws, *a_bs, *c_gn_g, *w_out, *ln1_g, *ln1_b;
  const float *w_gate, *w_up, *conv_w, *conv_b, *w_down, *ln2_g, *ln2_b;
  float* out;
  u16 *WinT, *WoutT, *WguT, *WdT, *xb, *proj, *mix, *hg, *hu;
  float *rope, *kvbuf;
  unsigned* bar;
  u16 *kic, *kc, *vc;
  u16 *zb1, *zb2;
};

__constant__ double FREQ_REV[32] = {
0.15915494309189535, 0.11934937021124886, 0.08949940160889101, 0.06711508300522726, 0.050329212104487035, 0.03774158471741977, 0.0283021958306234, 0.02122365276477766, 0.015915494309189534, 0.011934937021124886, 0.008949940160889102, 0.006711508300522725, 0.005032921210448704, 0.003774158471741977, 0.00283021958306234, 0.0021223652764777662, 0.0015915494309189536, 0.0011934937021124885, 0.0008949940160889102, 0.0006711508300522726, 0.0005032921210448703, 0.00037741584717419774, 0.00028302195830623395, 0.0002122365276477766, 0.00015915494309189535, 0.00011934937021124886, 8.949940160889102e-05, 6.711508300522725e-05, 5.0329212104487035e-05, 3.774158471741978e-05, 2.8302195830623396e-05, 2.122365276477766e-05};

__device__ __forceinline__ u16 f2bf(float f) { __bf16 h = (__bf16)f; return __builtin_bit_cast(u16, h); }
__device__ __forceinline__ float bf2f(u32 h) { return __uint_as_float(h << 16); }
typedef __bf16 bf2_t __attribute__((ext_vector_type(2)));
typedef float fl2_t __attribute__((ext_vector_type(2)));
typedef short s2_t __attribute__((ext_vector_type(2)));
__device__ __forceinline__ u32 pack2(float a, float b) { fl2_t f = {a, b}; bf2_t h = __builtin_convertvector(f, bf2_t); return __builtin_bit_cast(u32, h); }
__device__ __forceinline__ u32 pack2_relu(float a, float b) { u32 v = pack2(a, b); s2_t s = __builtin_bit_cast(s2_t, v); s2_t z = {0, 0}; s = __builtin_elementwise_max(s, z); return __builtin_bit_cast(u32, s); }
__device__ __forceinline__ float bflo(u32 w) { return __uint_as_float(w << 16); }
__device__ __forceinline__ float bfhi(u32 w) { return __uint_as_float(w & 0xffff0000u); }
__device__ __forceinline__ float gelu_f(float x) { float t = 1.5957691216f * (x + 0.044715f * x * x * x); return x / (1.f + __expf(-t)); }
__device__ __forceinline__ float silu_f(float x) { return x / (1.f + __expf(-x)); }
__device__ __forceinline__ bf16x8 pack8(float4 a, float4 b) {
  uint4 r; r.x = pack2(a.x, a.y); r.y = pack2(a.z, a.w); r.z = pack2(b.x, b.y); r.w = pack2(b.z, b.w);
  return __builtin_bit_cast(bf16x8, r);
}
__device__ __forceinline__ f32x4 mfma16(bf16x8 a, bf16x8 b, f32x4 c) { return __builtin_amdgcn_mfma_f32_16x16x32_bf16(a, b, c, 0, 0, 0); }
__device__ __forceinline__ f32x16 mfma32(bf16x8 a, bf16x8 b, f32x16 c) { return __builtin_amdgcn_mfma_f32_32x32x16_bf16(a, b, c, 0, 0, 0); }
__device__ __forceinline__ int TID() { int t = threadIdx.x; asm volatile("" : "+v"(t)); return t; }
__device__ __forceinline__ float head_lg(int h) { return logf(1.0f - exp2f(-5.0f - (float)h)); }


#define XB_TMO      128
#define XB_XCNT(j)  (256  + 64 * (j))
#define XB_XSUB(j)  (1280 + 64 * (j))
#define XB_XGEN(j)  (2304 + 64 * (j))
#define XB_TOP      3328
#define XB_TOPGEN   3392
#define XCD_BAR_WORDS 3456
#define XB_SPIN_CAP (1u << 22)
#define LAS __attribute__((address_space(3)))
__device__ __forceinline__ unsigned xb_ld(unsigned* p)              { return __hip_atomic_load(p, __ATOMIC_RELAXED, __HIP_MEMORY_SCOPE_AGENT); }
__device__ __forceinline__ unsigned xb_add(unsigned* p, unsigned v) { return __hip_atomic_fetch_add(p, v, __ATOMIC_RELAXED, __HIP_MEMORY_SCOPE_AGENT); }
__device__ __forceinline__ unsigned xb_xcc_id() { return (unsigned)__builtin_amdgcn_s_getreg((3 << 11) | 20) & 0xFu; }
#define XB_SPIN(cond, bar) do { unsigned _sp = 0; while (cond) { __builtin_amdgcn_s_sleep(1); \
    if ((++_sp & 255u) == 0u) { if (xb_ld(&(bar)[XB_TMO])) break; if (_sp > XB_SPIN_CAP) { atomicAdd(&(bar)[XB_TMO], 1u); break; } } } } while (0)
struct XcdBarrier { unsigned* bar; unsigned x; volatile LAS unsigned* st; };
__device__ __forceinline__ XcdBarrier xcd_barrier_post(unsigned* bar, volatile LAS unsigned* st) {
    XcdBarrier b; b.bar = bar; b.x = xb_xcc_id(); b.st = st;
    if (threadIdx.x == 0) (void)xb_add(&bar[XB_XCNT(b.x)], 1u);
    return b;
}
__device__ __forceinline__ void xcd_barrier_complete(unsigned* bar, unsigned x, unsigned& nloc, unsigned& nx) {
    const unsigned G = gridDim.x * gridDim.y * gridDim.z;
    unsigned sum, cnt, mine, sp = 0u;
    for (;;) {
        sum = 0u; cnt = 0u; mine = 0u;
#pragma unroll
        for (unsigned j = 0; j < 16; ++j) { const unsigned c = xb_ld(&bar[XB_XCNT(j)]); sum += c; cnt += (c > 0u) ? 1u : 0u; mine = (j == x) ? c : mine; }
        if (sum == G) break;
        __builtin_amdgcn_s_sleep(1);
        if ((++sp & 255u) == 0u) { if (xb_ld(&bar[XB_TMO])) break; if (sp > XB_SPIN_CAP) { atomicAdd(&bar[XB_TMO], 1u); break; } }
    }
    nloc = mine > 0u ? mine : 1u; nx = cnt > 0u ? cnt : 1u;
}
__device__ __forceinline__ void xcd_barrier(const XcdBarrier& b) {
    asm volatile("s_waitcnt vmcnt(0)" ::: "memory");
    __syncthreads();
    if (threadIdx.x == 0) {
        unsigned* bar = b.bar;
        __builtin_amdgcn_s_waitcnt(0);
        unsigned nloc = b.st[0], nx = b.st[1];
        if (nloc == 0u) { xcd_barrier_complete(bar, b.x, nloc, nx); b.st[0] = nloc; b.st[1] = nx; }
        const unsigned old = xb_add(&bar[XB_XSUB(b.x)], 1u);
        const unsigned gen = old / nloc;
        if (old + 1u == (gen + 1u) * nloc) {
            __builtin_amdgcn_fence(__ATOMIC_RELEASE, "agent");
            asm volatile("s_waitcnt vmcnt(0)" ::: "memory");
            const unsigned og = xb_add(&bar[XB_TOP], 1u);
            const unsigned tg = og / nx;
            if (og + 1u == (tg + 1u) * nx) xb_add(&bar[XB_TOPGEN], 1u);
            else XB_SPIN(xb_ld(&bar[XB_TOPGEN]) == tg, bar);
            __builtin_amdgcn_fence(__ATOMIC_ACQUIRE, "agent");
            xb_add(&bar[XB_XGEN(b.x)], 1u);
            asm volatile("s_waitcnt vmcnt(0)" ::: "memory");
        } else {
            XB_SPIN(xb_ld(&bar[XB_XGEN(b.x)]) == gen, bar);
            __builtin_amdgcn_fence(__ATOMIC_ACQUIRE, "agent");
            asm volatile("s_waitcnt vmcnt(0)" ::: "memory");
        }
    }
    __syncthreads();
}

__device__ __forceinline__ void transpose_tile(const float* __restrict__ W, int K, int N, u16* __restrict__ Wt, int k0, int n0, float* tile) {
  const int tid = TID();
#pragma unroll
  for (int i = 0; i < 4; ++i) {
    int idx = tid + i * 256; int kr = idx >> 4, c4 = (idx & 15) * 4; int n = n0 + c4;
    float4 v = make_float4(0.f, 0.f, 0.f, 0.f);
    if (n < N) v = *(const float4*)(W + (size_t)(k0 + kr) * N + n);
    float* t = tile + kr * 65 + c4; t[0] = v.x; t[1] = v.y; t[2] = v.z; t[3] = v.w;
  }
  __syncthreads();
#pragma unroll
  for (int i = 0; i < 2; ++i) {
    int idx = tid + i * 256; int j = idx >> 3, c = (idx & 7) * 8;
    uint4 r;
    r.x = pack2(tile[(c + 0) * 65 + j], tile[(c + 1) * 65 + j]);
    r.y = pack2(tile[(c + 2) * 65 + j], tile[(c + 3) * 65 + j]);
    r.z = pack2(tile[(c + 4) * 65 + j], tile[(c + 5) * 65 + j]);
    r.w = pack2(tile[(c + 6) * 65 + j], tile[(c + 7) * 65 + j]);
    *(uint4*)(Wt + (size_t)(n0 + j) * K + k0 + c) = r;
  }
  __syncthreads();
}

__device__ __forceinline__ void tt_load(const float* __restrict__ W, int N, int k0, int n0, int tid, float4* v) {
#pragma unroll
  for (int i = 0; i < 4; ++i) {
    int idx = tid + i * 256; int kr = idx >> 4, c4 = (idx & 15) * 4; int n = n0 + c4;
    v[i] = make_float4(0.f, 0.f, 0.f, 0.f);
    if (n < N) v[i] = *(const float4*)(W + (size_t)(k0 + kr) * N + n);
  }
}
__device__ __forceinline__ void tt_lds(const float4* v, int tid, float* tile) {
#pragma unroll
  for (int i = 0; i < 4; ++i) {
    int idx = tid + i * 256; int kr = idx >> 4, c4 = (idx & 15) * 4;
    float* t = tile + kr * 65 + c4; t[0] = v[i].x; t[1] = v[i].y; t[2] = v[i].z; t[3] = v[i].w;
  }
}
__device__ __forceinline__ void tt_out(u16* __restrict__ Wt, int K, int k0, int n0, int tid, const float* tile) {
#pragma unroll
  for (int i = 0; i < 2; ++i) {
    int idx = tid + i * 256; int j = idx >> 3, c = (idx & 7) * 8;
    uint4 r;
    r.x = pack2(tile[(c + 0) * 65 + j], tile[(c + 1) * 65 + j]);
    r.y = pack2(tile[(c + 2) * 65 + j], tile[(c + 3) * 65 + j]);
    r.z = pack2(tile[(c + 4) * 65 + j], tile[(c + 5) * 65 + j]);
    r.w = pack2(tile[(c + 6) * 65 + j], tile[(c + 7) * 65 + j]);
    *(uint4*)(Wt + (size_t)(n0 + j) * K + k0 + c) = r;
  }
}
struct TDesc { const float* W; u16* Wt; int K, N, k0, n0; };
__device__ __forceinline__ TDesc tt_decode(const P& p, int t);

constexpr int PT_WIN = 16 * 46, PT_WOUT = 256, PT_WG = 16 * 44, PT_WD = 44 * 16;
constexpr int PT_LAYER = PT_WIN + PT_WOUT + 2 * PT_WG + PT_WD;
constexpr int PT_X = NR * DM / 8192;
constexpr int PT_ROPE = 256;
constexpr int PT_TOTAL = 2 * PT_LAYER + PT_X + PT_ROPE;

__device__ __forceinline__ TDesc tt_decode(const P& p, int t) {
  TDesc d;
  int l = t / PT_LAYER, u = t % PT_LAYER;
  if (u < PT_WIN) { d.W = p.w_in + (size_t)l * DM * DPJ; d.K = DM; d.N = DPJ; d.Wt = p.WinT + (size_t)l * DPJP * DM; d.k0 = (u / 46) * 64; d.n0 = (u % 46) * 64; }
  else if ((u -= PT_WIN) < PT_WOUT) { d.W = p.w_out + (size_t)l * DM * DM; d.K = DM; d.N = DM; d.Wt = p.WoutT + (size_t)l * DM * DM; d.k0 = (u / 16) * 64; d.n0 = (u % 16) * 64; }
  else if ((u -= PT_WOUT) < PT_WG) { d.W = p.w_gate + (size_t)l * DM * DFF; d.K = DM; d.N = DFF; d.Wt = p.WguT + (size_t)l * 2 * DFF * DM; d.k0 = (u / 44) * 64; d.n0 = (u % 44) * 64; }
  else if ((u -= PT_WG) < PT_WG) { d.W = p.w_up + (size_t)l * DM * DFF; d.K = DM; d.N = DFF; d.Wt = p.WguT + (size_t)l * 2 * DFF * DM + (size_t)DFF * DM; d.k0 = (u / 44) * 64; d.n0 = (u % 44) * 64; }
  else { u -= PT_WG; d.W = p.w_down + (size_t)l * DFF * DM; d.K = DFF; d.N = DM; d.Wt = p.WdT + (size_t)l * DM * DFF; d.k0 = (u / 16) * 64; d.n0 = (u % 16) * 64; }
  return d;
}
__device__ __forceinline__ void prep_phase(const P& p, unsigned char* smem) {
  float* tile = (float*)smem;
  const int tid = TID();
  float* tile2 = tile + 64 * 65;
  for (int t = blockIdx.x; t < 2 * PT_LAYER; t += 2 * gridDim.x) {
    const TDesc a = tt_decode(p, t);
    const int t2 = t + gridDim.x;
    const bool hb = t2 < 2 * PT_LAYER;
    const TDesc b = tt_decode(p, hb ? t2 : t);
    float4 va[4], vb[4];
    tt_load(a.W, a.N, a.k0, a.n0, tid, va);
    if (hb) tt_load(b.W, b.N, b.k0, b.n0, tid, vb);
    tt_lds(va, tid, tile);
    if (hb) tt_lds(vb, tid, tile2);
    __syncthreads();
    tt_out(a.Wt, a.K, a.k0, a.n0, tid, tile);
    if (hb) tt_out(b.Wt, b.K, b.k0, b.n0, tid, tile2);
    __syncthreads();
  }
  for (int t = 2 * PT_LAYER + blockIdx.x; t < PT_TOTAL; t += gridDim.x) {
    if (false) {
    } else if (t < 2 * PT_LAYER + PT_X) {
      int u = t - 2 * PT_LAYER;
#pragma unroll
      for (int i = 0; i < 4; ++i) {
        size_t idx = ((size_t)u * 1024 + i * 256 + tid) * 8;
        const float* src = idx < (size_t)NPR * DM ? p.x_prompt + idx : p.x_sample + (idx - (size_t)NPR * DM);
        float4 a = ((const float4*)src)[0], b = ((const float4*)src)[1];
        *(bf16x8*)(p.xb + idx) = pack8(a, b);
      }
    } else {
      int u = t - 2 * PT_LAYER - PT_X;
#pragma unroll
      for (int i = 0; i < 4; ++i) {
        int e = u * 1024 + i * 256 + tid; int pos = e >> 5, ii = e & 31;
        double rev = (double)pos * FREQ_REV[ii];
        rev -= floor(rev);
        float fr = (float)rev;
        float2 cs; cs.x = __builtin_amdgcn_cosf(fr); cs.y = __builtin_amdgcn_sinf(fr);
        *(float2*)(p.rope + (size_t)e * 2) = cs;
      }
    }
  }
}

enum { EPI_IN = 0, EPI_OUT = 1, EPI_GU = 2, EPI_DOWN = 3 };

__device__ __forceinline__ void gemm_tile(const P& p, const int EPI, int layer, int slab_row0, const u16* __restrict__ Atile, int lda,
                                          const u16* __restrict__ Btile, int ldb, int K, int m0, int n0, unsigned char* smem, const bool dry) {
  const int tid = TID(), lane = tid & 63, wid = tid >> 6;
  const int wr = wid >> 1, wc = wid & 1;
  const int grow = tid >> 3, gcol = (((tid & 7) ^ ((tid >> 4) & 7)) << 3);
  const u16* ap = Atile + (size_t)grow * lda + gcol;
  const u16* bp = Btile + (size_t)grow * ldb + gcol;
  f32x4 acc[4][4];
#pragma unroll
  for (int i = 0; i < 4; ++i)
#pragma unroll
    for (int j = 0; j < 4; ++j) acc[i][j] = (f32x4){0.f, 0.f, 0.f, 0.f};
  const int nk = K >> 6;
  const int swr = (lane & 15) >> 1, q4 = lane >> 4;
  const int aoff = (wr * 64 + (lane & 15)) * 128 + ((q4 ^ swr) << 4);
  const int boff = 16384 + (wc * 64 + (lane & 15)) * 128 + ((q4 ^ swr) << 4);
  typedef __attribute__((address_space(3))) unsigned lds_u32;
#define G_DMA1(I, KT, ST) __builtin_amdgcn_global_load_lds((const unsigned*)(ap + (size_t)I * 32 * lda + (KT) * 64), (lds_u32*)(smem + (ST) * 32768 + I * 4096 + tid * 16), 16, 0, 0); \
                          __builtin_amdgcn_global_load_lds((const unsigned*)(bp + (size_t)I * 32 * ldb + (KT) * 64), (lds_u32*)(smem + (ST) * 32768 + 16384 + I * 4096 + tid * 16), 16, 0, 0);
#define G_DMA(KT, ST) { G_DMA1(0, KT, ST) G_DMA1(1, KT, ST) G_DMA1(2, KT, ST) G_DMA1(3, KT, ST) }
  const unsigned lbase = (unsigned)(size_t)((__attribute__((address_space(3))) unsigned char*)smem);
  const unsigned aad0 = lbase + aoff, aad1 = lbase + (aoff ^ 64), bad0 = lbase + boff, bad1 = lbase + (boff ^ 64);
#define LDSR(DST, ADDR, OFF) asm volatile("ds_read_b128 %0, %1 offset:%2" : "=v"(DST) : "v"(ADDR), "n"(OFF))
#define LWAIT8(A, B) asm volatile("s_waitcnt lgkmcnt(0)" : "+v"(A[0]), "+v"(A[1]), "+v"(A[2]), "+v"(A[3]), "+v"(B[0]), "+v"(B[1]), "+v"(B[2]), "+v"(B[3]) :: "memory")
#define G_COMPUTE(BUF) { bf16x8 af0[4], bf0[4], af1[4], bf1[4]; \
      LDSR(af0[0], aad0, (BUF) * 32768 + 0); LDSR(af0[1], aad0, (BUF) * 32768 + 2048); LDSR(af0[2], aad0, (BUF) * 32768 + 4096); LDSR(af0[3], aad0, (BUF) * 32768 + 6144); \
      LDSR(bf0[0], bad0, (BUF) * 32768 + 0); LDSR(bf0[1], bad0, (BUF) * 32768 + 2048); LDSR(bf0[2], bad0, (BUF) * 32768 + 4096); LDSR(bf0[3], bad0, (BUF) * 32768 + 6144); \
      LWAIT8(af0, bf0); \
      LDSR(af1[0], aad1, (BUF) * 32768 + 0); LDSR(af1[1], aad1, (BUF) * 32768 + 2048); LDSR(af1[2], aad1, (BUF) * 32768 + 4096); LDSR(af1[3], aad1, (BUF) * 32768 + 6144); \
      LDSR(bf1[0], bad1, (BUF) * 32768 + 0); LDSR(bf1[1], bad1, (BUF) * 32768 + 2048); LDSR(bf1[2], bad1, (BUF) * 32768 + 4096); LDSR(bf1[3], bad1, (BUF) * 32768 + 6144); \
      __builtin_amdgcn_s_setprio(1); \
      _Pragma("unroll") for (int i = 0; i < 4; ++i) _Pragma("unroll") for (int j = 0; j < 4; ++j) acc[i][j] = mfma16(bf0[j], af0[i], acc[i][j]); \
      LWAIT8(af1, bf1); \
      _Pragma("unroll") for (int i = 0; i < 4; ++i) _Pragma("unroll") for (int j = 0; j < 4; ++j) acc[i][j] = mfma16(bf1[j], af1[i], acc[i][j]); \
      __builtin_amdgcn_s_setprio(0); }
  G_DMA(0, 0);
  __syncthreads();
  for (int kt = 0; kt < nk; kt += 2) {
    G_DMA(kt + 1, 1);
    G_COMPUTE(0);
    __syncthreads();
    if (kt + 2 < nk) G_DMA(kt + 2, 0);
    G_COMPUTE(1);
    __syncthreads();
  }
#undef G_DMA
#undef G_DMA1
#undef G_COMPUTE
#undef LDSR
#undef LWAIT8
  if (dry) return;
#pragma unroll
  for (int mt = 0; mt < 4; ++mt) {
    const int row = m0 + wr * 64 + mt * 16 + (lane & 15);
#pragma unroll
    for (int nt = 0; nt < 4; ++nt) {
      const int col = n0 + wc * 64 + nt * 16 + (lane >> 4) * 4;
      f32x4 a = acc[mt][nt];
      if (EPI == EPI_IN) {
        if (col < DPJ) {
          uint2 pk; pk.x = pack2(a[0], a[1]); pk.y = pack2(a[2], a[3]);
          *(uint2*)(p.proj + (size_t)row * DPJ + col) = pk;
          if (col >= C_KB && col < C_QI) {
            bool isv = col >= C_VB; int cc = col - (isv ? C_VB : C_KB);
            float* dst = (row < NPR) ? p.out + (isv ? OFF_VP : OFF_KP) + ((size_t)layer * NPR + row) * 64 + cc
                                     : p.out + (isv ? OFF_VS : OFF_KS) + ((size_t)layer * NSR + (row - NPR)) * 64 + cc;
            *(float4*)dst = make_float4(a[0], a[1], a[2], a[3]);
            *(uint2*)((isv ? p.vc : p.kc) + (size_t)row * 64 + cc) = pk;
          } else if (col >= C_KI && col < C_WI) {
            int cc = col - C_KI;
            *(uint2*)(p.kic + (size_t)row * 32 + cc) = pk;
            float* dst = (row < NPR) ? p.out + OFF_KIP + ((size_t)layer * NPR + row) * 32 + cc
                                     : p.out + OFF_KIS + ((size_t)layer * NSR + (row - NPR)) * 32 + cc;
            *(float4*)dst = make_float4(a[0], a[1], a[2], a[3]);
          }
        }
      } else if (EPI == EPI_OUT) {
        float4 xv;
        if (layer == 0) {
          const float* xin = row < NPR ? p.x_prompt + (size_t)row * DM : p.x_sample + (size_t)(row - NPR) * DM;
          xv = *(const float4*)(xin + col);
        } else {
          uint2 xr = *(const uint2*)(p.xb + (size_t)row * DM + col);
          xv = make_float4(bflo(xr.x), bfhi(xr.x), bflo(xr.y), bfhi(xr.y));
        }
        { uint2 zk; zk.x = pack2(ALPHA * xv.x + a[0], ALPHA * xv.y + a[1]); zk.y = pack2(ALPHA * xv.z + a[2], ALPHA * xv.w + a[3]);
          *(uint2*)(p.zb1 + (size_t)row * DM + col) = zk; }
      } else if (EPI == EPI_GU) {
        const int hrow = row - slab_row0;
        uint2 pk; pk.x = pack2(a[0], a[1]); pk.y = pack2(a[2], a[3]);
        if (col < DFF) {
          *(uint2*)(p.hg + (size_t)hrow * DFF + col) = pk;
          if (row < NPR) {
            int t = row & 8191;
            if (t >= 8190) *(float4*)(p.out + OFF_CP + ((size_t)(layer * 2 + (row >> 13)) * 2 + (t - 8190)) * DFF + col) = make_float4(a[0], a[1], a[2], a[3]);
          } else {
            int rs = row - NPR, t = rs & 15;
            if (t >= 14) *(float4*)(p.out + OFF_CS + ((size_t)(layer * 32 + (rs >> 4)) * 2 + (t - 14)) * DFF + col) = make_float4(a[0], a[1], a[2], a[3]);
          }
        } else {
          *(uint2*)(p.hu + (size_t)hrow * DFF + (col - DFF)) = pk;
        }
      } else {
        uint2 xr = *(const uint2*)(p.xb + (size_t)row * DM + col);
        uint2 zk; zk.x = pack2(ALPHA * bflo(xr.x) + a[0], ALPHA * bfhi(xr.x) + a[1]); zk.y = pack2(ALPHA * bflo(xr.y) + a[2], ALPHA * bfhi(xr.y) + a[3]);
        *(uint2*)(p.zb2 + (size_t)row * DM + col) = zk;
      }
    }
  }
}

__device__ __forceinline__ void ln_phase(const P& p, const float* __restrict__ g, const float* __restrict__ b, const bool dry, const bool wr_f32, const bool wr_bf16, const u16* __restrict__ zsrc) {
  const int tid_ = TID(); const int lane = tid_ & 63, wid = tid_ >> 6;
  const int gw = blockIdx.x * 4 + wid, nw = gridDim.x * 4;
  const int r0 = (int)(((long)gw * NR) / nw), r1 = (int)(((long)(gw + 1) * NR) / nw);
  for (int rb = r0; rb < r1; rb += 5) {
    float4 v[5][4];
#pragma unroll
    for (int rr = 0; rr < 5; ++rr) {
      const int rowl = (rb + rr < r1) ? rb + rr : r1 - 1;
      const u16* zr = zsrc + (size_t)rowl * DM;
#pragma unroll
      for (int i = 0; i < 4; ++i) { uint2 zz = *(const uint2*)(zr + i * 256 + lane * 4); v[rr][i] = make_float4(bflo(zz.x), bfhi(zz.x), bflo(zz.y), bfhi(zz.y)); }
    }
#pragma unroll
    for (int rr = 0; rr < 5; ++rr) {
      const int row = rb + rr;
      if (row >= r1) break;
      float* xr = p.out + (size_t)row * DM;
      float s = 0.f;
#pragma unroll
      for (int i = 0; i < 4; ++i) s += v[rr][i].x + v[rr][i].y + v[rr][i].z + v[rr][i].w;
#pragma unroll
      for (int o = 1; o < 64; o <<= 1) s += __shfl_xor(s, o);
      const float mean = s * (1.f / 1024.f);
      float q = 0.f;
#pragma unroll
      for (int i = 0; i < 4; ++i) { float a = v[rr][i].x - mean, bb = v[rr][i].y - mean, c = v[rr][i].z - mean, d = v[rr][i].w - mean; q += a * a + bb * bb + c * c + d * d; }
#pragma unroll
      for (int o = 1; o < 64; o <<= 1) q += __shfl_xor(q, o);
      const float rstd = rsqrtf(q * (1.f / 1024.f) + 1e-5f);
      if (!dry) {
#pragma unroll
        for (int i = 0; i < 4; ++i) {
          const int c = i * 256 + lane * 4;
          float4 gg = *(const float4*)(g + c), bb = *(const float4*)(b + c);
          float4 y;
          y.x = (v[rr][i].x - mean) * rstd * gg.x + bb.x; y.y = (v[rr][i].y - mean) * rstd * gg.y + bb.y;
          y.z = (v[rr][i].z - mean) * rstd * gg.z + bb.z; y.w = (v[rr][i].w - mean) * rstd * gg.w + bb.w;
          if (wr_f32) *(float4*)(xr + c) = y;
          if (wr_bf16) { uint2 pk; pk.x = pack2(y.x, y.y); pk.y = pack2(y.z, y.w); *(uint2*)(p.xb + (size_t)row * DM + c) = pk; }
        }
      }
    }
  }
}

__device__ __forceinline__ void unpack8(uint4 a, float* f) {
  f[0] = bflo(a.x); f[1] = bfhi(a.x); f[2] = bflo(a.y); f[3] = bfhi(a.y); f[4] = bflo(a.z); f[5] = bfhi(a.z); f[6] = bflo(a.w); f[7] = bfhi(a.w);
}
__device__ __forceinline__ void act_phase(const P& p, int layer, int slab, int slab_rows, const bool dry, const int bskip) {
  const int tid = TID();
  const int nitems = (slab_rows / 8) * (DFF / 8);
  const int ntask = (nitems + 255) / 256;
  const float* cw = p.conv_w + (size_t)layer * 3 * DFF;
  const float* cb = p.conv_b + (size_t)layer * DFF;
  if ((int)blockIdx.x < bskip) return;
  for (int t = blockIdx.x - bskip; t < ntask; t += gridDim.x - bskip) {
    const int item = t * 256 + tid;
    if (item < nitems) {
      const int rg = item / (DFF / 8), cc = item % (DFF / 8);
      const int c0 = cc * 8;
      const int hrow0 = rg * 8;
      const int row0 = (slab == 0) ? (hrow0 < 8192 ? hrow0 : NPR + (hrow0 - 8192)) : 8192 + hrow0;
      const int tt = (row0 < NPR) ? (row0 & 8191) : ((row0 - NPR) & 15);
      uint4 hgv[8], huv[8];
#pragma unroll
      for (int r = 0; r < 8; ++r) { hgv[r] = *(const uint4*)(p.hg + (size_t)(hrow0 + r) * DFF + c0); huv[r] = *(const uint4*)(p.hu + (size_t)(hrow0 + r) * DFF + c0); }
      float h1[8], h2[8];
      if (tt == 0) {
        if (row0 < NPR) {
#pragma unroll
          for (int e = 0; e < 8; ++e) { h1[e] = 0.f; h2[e] = 0.f; }
        } else {
          const float* st = p.state_conv + ((size_t)(layer * 32 + ((row0 - NPR) >> 4)) * 2) * DFF + c0;
#pragma unroll
          for (int e = 0; e < 8; ++e) { h2[e] = st[e]; h1[e] = st[DFF + e]; }
        }
      } else {
        unpack8(*(const uint4*)(p.hg + (size_t)(hrow0 - 1) * DFF + c0), h1);
        unpack8(*(const uint4*)(p.hg + (size_t)(hrow0 - 2) * DFF + c0), h2);
      }
      float w0[8], w1[8], w2[8], bb[8];
#pragma unroll
      for (int e = 0; e < 8; ++e) { w0[e] = cw[c0 + e]; w1[e] = cw[DFF + c0 + e]; w2[e] = cw[2 * DFF + c0 + e]; bb[e] = cb[c0 + e]; }
#pragma unroll
      for (int r = 0; r < 8; ++r) {
        float h0[8], uu[8], o[8];
        unpack8(hgv[r], h0); unpack8(huv[r], uu);
#pragma unroll
        for (int e = 0; e < 8; ++e) {
          float cv = bb[e] + w0[e] * h2[e] + w1[e] * h1[e] + w2[e] * h0[e];
          o[e] = gelu_f(cv) * uu[e];
          h2[e] = h1[e]; h1[e] = h0[e];
        }
        uint4 r4; r4.x = pack2(o[0], o[1]); r4.y = pack2(o[2], o[3]); r4.z = pack2(o[4], o[5]); r4.w = pack2(o[6], o[7]);
        if (!dry) *(uint4*)(p.hu + (size_t)(hrow0 + r) * DFF + c0) = r4;
      }
    }
  }
}

__device__ __forceinline__ void mixer_a_task(const P& p, int layer, int task, unsigned char* smem) {
  const int tid = TID(), lane = tid & 63, w = tid >> 6;
  int g, row0, CL, sb = 0; bool samp = false;
  if (task < 512) { g = task & 3; row0 = (task >> 2) * 128; CL = 128; }
  else { int ts = task - 512; g = ts & 3; sb = ts >> 2; row0 = NPR + sb * 16; CL = 16; samp = true; }
  u16* vnT = (u16*)smem;
  {
    const int r = tid >> 1, half = tid & 1;
    float v[32];
    if (r < CL) {
      const uint4* src = (const uint4*)(p.proj + (size_t)(row0 + r) * DPJ + C_VA + g * 64 + half * 32);
#pragma unroll
      for (int i = 0; i < 4; ++i) {
        uint4 a = src[i];
        v[i * 8 + 0] = gelu_f(bflo(a.x)); v[i * 8 + 1] = gelu_f(bfhi(a.x)); v[i * 8 + 2] = gelu_f(bflo(a.y)); v[i * 8 + 3] = gelu_f(bfhi(a.y));
        v[i * 8 + 4] = gelu_f(bflo(a.z)); v[i * 8 + 5] = gelu_f(bfhi(a.z)); v[i * 8 + 6] = gelu_f(bflo(a.w)); v[i * 8 + 7] = gelu_f(bfhi(a.w));
      }
    } else {
#pragma unroll
      for (int i = 0; i < 32; ++i) v[i] = 0.f;
    }
    float s = 0.f;
#pragma unroll
    for (int i = 0; i < 32; ++i) s += v[i];
    s += __shfl_xor(s, 1);
    const float mean = s * (1.f / 64.f);
    float q = 0.f;
#pragma unroll
    for (int i = 0; i < 32; ++i) { float d = v[i] - mean; q += d * d; }
    q += __shfl_xor(q, 1);
    const float rstd = rsqrtf(q * (1.f / 64.f) + 1e-5f);
    const float* lg = p.a_ln_g + layer * 256 + g * 64 + half * 32;
    const float* lb = p.a_ln_b + layer * 256 + g * 64 + half * 32;
#pragma unroll
    for (int i = 0; i < 32; ++i) {
      float y = (r < CL) ? (v[i] - mean) * rstd * lg[i] + lb[i] : 0.f;
      v[i] = y;
      vnT[(half * 32 + i) * 136 + r] = f2bf(y);
    }
    if (samp && r < CL) {
      float* dst = p.out + OFF_AV + ((size_t)(layer * 32 + sb) * 16 + r) * 256 + g * 64 + half * 32;
#pragma unroll
      for (int i = 0; i < 8; ++i) *(float4*)(dst + i * 4) = make_float4(v[i * 4], v[i * 4 + 1], v[i * 4 + 2], v[i * 4 + 3]);
    }
  }
  __syncthreads();
  {
    const int i0 = w * 32;
    f32x4 acc[2][4];
#pragma unroll
    for (int i = 0; i < 2; ++i)
#pragma unroll
      for (int j = 0; j < 4; ++j) acc[i][j] = (f32x4){0.f, 0.f, 0.f, 0.f};
    const float* Wg = p.a_ws + (size_t)(layer * 4 + g) * 128 * 128;
    if (i0 < CL) {
      for (int ks = 0; ks < 4; ++ks) {
        if (ks * 32 > i0 + 31 || ks * 32 >= CL) break;
        bf16x8 bfr[4];
#pragma unroll
        for (int nt = 0; nt < 4; ++nt) bfr[nt] = *(const bf16x8*)(vnT + (nt * 16 + (lane & 15)) * 136 + ks * 32 + (lane >> 4) * 8);
#pragma unroll
        for (int mt = 0; mt < 2; ++mt) {
          const int i = i0 + mt * 16 + (lane & 15);
          const int j0 = ks * 32 + (lane >> 4) * 8;
          const float* wp = Wg + (size_t)i * 128 + j0;
          float4 a = ((const float4*)wp)[0], b = ((const float4*)wp)[1];
          a.x = (j0 + 0 <= i) ? a.x : 0.f; a.y = (j0 + 1 <= i) ? a.y : 0.f; a.z = (j0 + 2 <= i) ? a.z : 0.f; a.w = (j0 + 3 <= i) ? a.w : 0.f;
          b.x = (j0 + 4 <= i) ? b.x : 0.f; b.y = (j0 + 5 <= i) ? b.y : 0.f; b.z = (j0 + 6 <= i) ? b.z : 0.f; b.w = (j0 + 7 <= i) ? b.w : 0.f;
          bf16x8 af = pack8(a, b);
#pragma unroll
          for (int nt = 0; nt < 4; ++nt) acc[mt][nt] = mfma16(bfr[nt], af, acc[mt][nt]);
        }
      }
#pragma unroll
      for (int mt = 0; mt < 2; ++mt) {
        const int i = i0 + mt * 16 + (lane & 15);
        if (i < CL) {
          const float bsv = p.a_bs[(layer * 4 + g) * 128 + i];
#pragma unroll
          for (int nt = 0; nt < 4; ++nt) {
            const int c = nt * 16 + (lane >> 4) * 4;
            uint2 u = *(const uint2*)(p.proj + (size_t)(row0 + i) * DPJ + C_UA + g * 64 + c);
            f32x4 a = acc[mt][nt];
            uint2 o;
            o.x = pack2(gelu_f(bflo(u.x)) * (a[0] + bsv), gelu_f(bfhi(u.x)) * (a[1] + bsv));
            o.y = pack2(gelu_f(bflo(u.y)) * (a[2] + bsv), gelu_f(bfhi(u.y)) * (a[3] + bsv));
            *(uint2*)(p.mix + (size_t)(row0 + i) * DM + g * 64 + c) = o;
          }
        }
      }
    }
  }
  __syncthreads();
}

__device__ __forceinline__ void ret_decode(int task, int& h, int& row0, int& CL, int& pos0, int& bidx, int& n, bool& samp) {
  if (task < 1536) { h = task % 6; int cn = task / 6; bidx = cn >> 7; n = cn & 127; row0 = cn * 64; CL = 64; pos0 = n * 64; samp = false; }
  else { int ts = task - 1536; h = ts % 6; bidx = ts / 6; n = 0; row0 = NPR + bidx * 16; CL = 16; pos0 = 2048; samp = true; }
}

__device__ __forceinline__ void rope_load(const P& p, const u16* src  , int q4, int pos, float scale, float* o1, float* o2) {
  uint4 a = *(const uint4*)(src + q4 * 8);
  uint4 b = *(const uint4*)(src + 32 + q4 * 8);
  float x1[8], x2[8];
  x1[0] = bflo(a.x); x1[1] = bfhi(a.x); x1[2] = bflo(a.y); x1[3] = bfhi(a.y); x1[4] = bflo(a.z); x1[5] = bfhi(a.z); x1[6] = bflo(a.w); x1[7] = bfhi(a.w);
  x2[0] = bflo(b.x); x2[1] = bfhi(b.x); x2[2] = bflo(b.y); x2[3] = bfhi(b.y); x2[4] = bflo(b.z); x2[5] = bfhi(b.z); x2[6] = bflo(b.w); x2[7] = bfhi(b.w);
  const float4* rp = (const float4*)(p.rope + ((size_t)pos * 32 + q4 * 8) * 2);
#pragma unroll
  for (int e = 0; e < 4; ++e) {
    float4 cs = rp[e];
    o1[2 * e] = (x1[2 * e] * cs.x - x2[2 * e] * cs.y) * scale;
    o2[2 * e] = (x1[2 * e] * cs.y + x2[2 * e] * cs.x) * scale;
    o1[2 * e + 1] = (x1[2 * e + 1] * cs.z - x2[2 * e + 1] * cs.w) * scale;
    o2[2 * e + 1] = (x1[2 * e + 1] * cs.w + x2[2 * e + 1] * cs.z) * scale;
  }
}

__device__ __forceinline__ void ret_kv_task(const P& p, int layer, int task, unsigned char* smem) {
  const int tid = TID(), lane = tid & 63, w = tid >> 6;
  int h, row0, CL, pos0, bidx, n; bool samp;
  ret_decode(task, h, row0, CL, pos0, bidx, n, samp);
  const float lg = head_lg(h);
  u16* kT = (u16*)smem;
  u16* vT = (u16*)(smem + 9216);
  {
    const int j = tid >> 2, q4 = tid & 3;
    if (j < CL) {
      float o1[8], o2[8];
      const float dec = 0.125f * __expf((float)(CL - 1 - j) * lg);
      rope_load(p, p.proj + (size_t)(row0 + j) * DPJ + C_KC + h * 64, q4, pos0 + j, dec, o1, o2);
#pragma unroll
      for (int e = 0; e < 8; ++e) { kT[(q4 * 8 + e) * 72 + j] = f2bf(o1[e]); kT[(32 + q4 * 8 + e) * 72 + j] = f2bf(o2[e]); }
      const uint4* vs = (const uint4*)(p.proj + (size_t)(row0 + j) * DPJ + C_VC + h * 64 + q4 * 16);
      uint4 a = vs[0], b = vs[1];
      u32 ww[8] = {a.x, a.y, a.z, a.w, b.x, b.y, b.z, b.w};
#pragma unroll
      for (int e = 0; e < 8; ++e) { vT[(q4 * 16 + 2 * e) * 72 + j] = (u16)(ww[e] & 0xffff); vT[(q4 * 16 + 2 * e + 1) * 72 + j] = (u16)(ww[e] >> 16); }
    } else {
#pragma unroll
      for (int e = 0; e < 8; ++e) { kT[(q4 * 8 + e) * 72 + j] = 0; kT[(32 + q4 * 8 + e) * 72 + j] = 0; }
#pragma unroll
      for (int e = 0; e < 16; ++e) vT[(q4 * 16 + e) * 72 + j] = 0;
    }
  }
  __syncthreads();
  {
    f32x4 acc[4];
#pragma unroll
    for (int nt = 0; nt < 4; ++nt) acc[nt] = (f32x4){0.f, 0.f, 0.f, 0.f};
#pragma unroll
    for (int ks = 0; ks < 2; ++ks) {
      bf16x8 af = *(const bf16x8*)(kT + (w * 16 + (lane & 15)) * 72 + ks * 32 + (lane >> 4) * 8);
#pragma unroll
      for (int nt = 0; nt < 4; ++nt) {
        bf16x8 bfr = *(const bf16x8*)(vT + (nt * 16 + (lane & 15)) * 72 + ks * 32 + (lane >> 4) * 8);
        acc[nt] = mfma16(bfr, af, acc[nt]);
      }
    }
    const int d = w * 16 + (lane & 15);
#pragma unroll
    for (int nt = 0; nt < 4; ++nt) {
      const int e = nt * 16 + (lane >> 4) * 4;
      if (!samp) {
        *(float4*)(p.kvbuf + (((size_t)(bidx * 6 + h) * 128 + n) * 64 + d) * 64 + e) = make_float4(acc[nt][0], acc[nt][1], acc[nt][2], acc[nt][3]);
      } else {
        const size_t o = ((size_t)(layer * 32 + bidx) * 6 + h) * 4096 + d * 64 + e;
        float4 r0 = *(const float4*)(p.state_ret + o);
        const float cd = __expf(16.f * lg);
        *(float4*)(p.out + OFF_RS + o) = make_float4(cd * r0.x + acc[nt][0], cd * r0.y + acc[nt][1], cd * r0.z + acc[nt][2], cd * r0.w + acc[nt][3]);
      }
    }
  }
  __syncthreads();
}

__device__ __forceinline__ void scan_phase(const P& p, int layer, const bool dry) {
  const int tid = TID();
  for (int t = blockIdx.x; t < 192; t += gridDim.x) {
    const int bh = t >> 4, part = t & 15;
    const int h = bh % 6;
    const float cd = __expf(64.f * head_lg(h));
    float* base = p.kvbuf + (size_t)bh * 128 * 4096 + part * 256 + tid;
    float r = 0.f;
    for (int n0 = 0; n0 < 128; n0 += 32) {
      float kv[32];
#pragma unroll
      for (int i = 0; i < 32; ++i) kv[i] = base[(size_t)(n0 + i) * 4096];
#pragma unroll
      for (int i = 0; i < 32; ++i) {
        if (!dry) base[(size_t)(n0 + i) * 4096] = r;
        r = cd * r + kv[i];
      }
    }
    if (!dry || r == 1.2345e30f) p.out[OFF_RP + ((size_t)layer * 12 + bh) * 4096 + part * 256 + tid] = r;
  }
}

__device__ __forceinline__ void ret_out_task(const P& p, int layer, int task, unsigned char* smem) {
  const int tid = TID(), lane = tid & 63, w = tid >> 6;
  int h, row0, CL, pos0, bidx, n; bool samp;
  ret_decode(task, h, row0, CL, pos0, bidx, n, samp);
  const float lg = head_lg(h);
  u16* sQ = (u16*)smem; u16* sK = sQ + 4608; u16* sVT = sK + 4608; u16* sRT = sVT + 4608; u16* sS = sRT + 4608;
  {
    const int j = tid >> 2, q4 = tid & 3;
    if (j < CL) {
      float o1[8], o2[8];
      rope_load(p, p.proj + (size_t)(row0 + j) * DPJ + C_QC + h * 64, q4, pos0 + j, 1.0f, o1, o2);
      *(bf16x8*)(sQ + j * 72 + q4 * 8) = pack8(make_float4(o1[0], o1[1], o1[2], o1[3]), make_float4(o1[4], o1[5], o1[6], o1[7]));
      *(bf16x8*)(sQ + j * 72 + 32 + q4 * 8) = pack8(make_float4(o2[0], o2[1], o2[2], o2[3]), make_float4(o2[4], o2[5], o2[6], o2[7]));
      rope_load(p, p.proj + (size_t)(row0 + j) * DPJ + C_KC + h * 64, q4, pos0 + j, 0.125f, o1, o2);
      *(bf16x8*)(sK + j * 72 + q4 * 8) = pack8(make_float4(o1[0], o1[1], o1[2], o1[3]), make_float4(o1[4], o1[5], o1[6], o1[7]));
      *(bf16x8*)(sK + j * 72 + 32 + q4 * 8) = pack8(make_float4(o2[0], o2[1], o2[2], o2[3]), make_float4(o2[4], o2[5], o2[6], o2[7]));
      const uint4* vs = (const uint4*)(p.proj + (size_t)(row0 + j) * DPJ + C_VC + h * 64 + q4 * 16);
      uint4 a = vs[0], b = vs[1];
      u32 ww[8] = {a.x, a.y, a.z, a.w, b.x, b.y, b.z, b.w};
#pragma unroll
      for (int e = 0; e < 8; ++e) { sVT[(q4 * 16 + 2 * e) * 72 + j] = (u16)(ww[e] & 0xffff); sVT[(q4 * 16 + 2 * e + 1) * 72 + j] = (u16)(ww[e] >> 16); }
    } else {
      uint4 z = make_uint4(0, 0, 0, 0);
      *(uint4*)(sQ + j * 72 + q4 * 8) = z; *(uint4*)(sQ + j * 72 + 32 + q4 * 8) = z;
      *(uint4*)(sK + j * 72 + q4 * 8) = z; *(uint4*)(sK + j * 72 + 32 + q4 * 8) = z;
#pragma unroll
      for (int e = 0; e < 16; ++e) sVT[(q4 * 16 + e) * 72 + j] = 0;
    }
    const int d = tid >> 2;
    const float* rsrc = samp ? p.state_ret + ((size_t)(layer * 32 + bidx) * 6 + h) * 4096 + d * 64 + q4 * 16
                             : p.kvbuf + (((size_t)(bidx * 6 + h) * 128 + n) * 64 + d) * 64 + q4 * 16;
#pragma unroll
    for (int i = 0; i < 4; ++i) {
      float4 r = ((const float4*)rsrc)[i];
      sRT[(q4 * 16 + i * 4 + 0) * 72 + d] = f2bf(r.x); sRT[(q4 * 16 + i * 4 + 1) * 72 + d] = f2bf(r.y);
      sRT[(q4 * 16 + i * 4 + 2) * 72 + d] = f2bf(r.z); sRT[(q4 * 16 + i * 4 + 3) * 72 + d] = f2bf(r.w);
    }
  }
  __syncthreads();
  const bool active = (w * 16 < CL);
  if (active) {
    bf16x8 qf0 = *(const bf16x8*)(sQ + (w * 16 + (lane & 15)) * 72 + (lane >> 4) * 8);
    bf16x8 qf1 = *(const bf16x8*)(sQ + (w * 16 + (lane & 15)) * 72 + 32 + (lane >> 4) * 8);
    const int ia = w * 16 + (lane & 15);
    for (int jt = 0; jt < 4; ++jt) {
      uint2 pk = make_uint2(0, 0);
      if (jt <= w) {
        f32x4 acc = (f32x4){0.f, 0.f, 0.f, 0.f};
        bf16x8 kf0 = *(const bf16x8*)(sK + (jt * 16 + (lane & 15)) * 72 + (lane >> 4) * 8);
        bf16x8 kf1 = *(const bf16x8*)(sK + (jt * 16 + (lane & 15)) * 72 + 32 + (lane >> 4) * 8);
        acc = mfma16(kf0, qf0, acc); acc = mfma16(kf1, qf1, acc);
        const int ja = jt * 16 + (lane >> 4) * 4;
        float s[4];
#pragma unroll
        for (int jj = 0; jj < 4; ++jj) { int df = ia - (ja + jj); s[jj] = (df >= 0) ? acc[jj] * __expf((float)df * lg) : 0.f; }
        pk.x = pack2(s[0], s[1]); pk.y = pack2(s[2], s[3]);
      }
      *(uint2*)(sS + ia * 72 + jt * 16 + (lane >> 4) * 4) = pk;
    }
  }
  __syncthreads();
  if (active) {
    f32x4 ai[4], ac[4];
#pragma unroll
    for (int nt = 0; nt < 4; ++nt) { ai[nt] = (f32x4){0.f, 0.f, 0.f, 0.f}; ac[nt] = (f32x4){0.f, 0.f, 0.f, 0.f}; }
#pragma unroll
    for (int ks = 0; ks < 2; ++ks) {
      bf16x8 sf = *(const bf16x8*)(sS + (w * 16 + (lane & 15)) * 72 + ks * 32 + (lane >> 4) * 8);
      bf16x8 qf = *(const bf16x8*)(sQ + (w * 16 + (lane & 15)) * 72 + ks * 32 + (lane >> 4) * 8);
#pragma unroll
      for (int nt = 0; nt < 4; ++nt) {
        bf16x8 vf = *(const bf16x8*)(sVT + (nt * 16 + (lane & 15)) * 72 + ks * 32 + (lane >> 4) * 8);
        bf16x8 rf = *(const bf16x8*)(sRT + (nt * 16 + (lane & 15)) * 72 + ks * 32 + (lane >> 4) * 8);
        ai[nt] = mfma16(vf, sf, ai[nt]); ac[nt] = mfma16(rf, qf, ac[nt]);
      }
    }
    const int il = w * 16 + (lane & 15);
    const float qd = __expf((float)(il + 1) * lg);
    float y[16]; float s = 0.f;
#pragma unroll
    for (int nt = 0; nt < 4; ++nt)
#pragma unroll
      for (int jj = 0; jj < 4; ++jj) { y[nt * 4 + jj] = ai[nt][jj] + qd * ac[nt][jj]; s += y[nt * 4 + jj]; }
    s += __shfl_xor(s, 16); s += __shfl_xor(s, 32);
    const float mean = s * (1.f / 64.f);
    float q = 0.f;
#pragma unroll
    for (int i = 0; i < 16; ++i) { float dd = y[i] - mean; q += dd * dd; }
    q += __shfl_xor(q, 16); q += __shfl_xor(q, 32);
    const float rstd = rsqrtf(q * (1.f / 64.f) + 1e-5f);
    if (il < CL) {
#pragma unroll
      for (int nt = 0; nt < 4; ++nt) {
        const int e = nt * 16 + (lane >> 4) * 4;
        float4 gg = *(const float4*)(p.c_gn_g + layer * 384 + h * 64 + e);
        uint2 gr = *(const uint2*)(p.proj + (size_t)(row0 + il) * DPJ + C_GC + h * 64 + e);
        uint2 o;
        o.x = pack2(silu_f(bflo(gr.x)) * (y[nt * 4 + 0] - mean) * rstd * gg.x, silu_f(bfhi(gr.x)) * (y[nt * 4 + 1] - mean) * rstd * gg.y);
        o.y = pack2(silu_f(bflo(gr.y)) * (y[nt * 4 + 2] - mean) * rstd * gg.z, silu_f(bfhi(gr.y)) * (y[nt * 4 + 3] - mean) * rstd * gg.w);
        *(uint2*)(p.mix + (size_t)(row0 + il) * DM + 640 + h * 64 + e) = o;
      }
    }
  }
  __syncthreads();
}

constexpr int DS_SEL = 32768, DS_CS = 36864, DS_CI = 40960, DS_STAT = 43008, DS_THR = 43072, DS_CNT = 43136, DS_NV = 43200;
constexpr int CANDC = 128;

template <bool SAMPLE> __forceinline__
__device__ __forceinline__ void dsa_task(const P& p, int layer, int qrow0, int kb_row0, int sb, int L, unsigned char* smem) {
  const int tid = TID(), lane = tid & 63, w = tid >> 6;
  u32* hist = (u32*)smem;
  u16* sel = (u16*)(smem + DS_SEL);
  float* cand_s = (float*)(smem + DS_CS);
  u16* cand_i = (u16*)(smem + DS_CI);
  float* stats = (float*)(smem + DS_STAT);
  int* thr = (int*)(smem + DS_THR);
  u32* cnt = (u32*)(smem + DS_CNT);
  int* nval = (int*)(smem + DS_NV);

  auto ki_frag = [&](int key, int koff) -> bf16x8 {
    if (SAMPLE) {
      if (key < 2048) {
        const float* f = p.cache_ki + (((size_t)layer * 32 + sb) * 2048 + key) * 32 + koff;
        return pack8(((const float4*)f)[0], ((const float4*)f)[1]);
      }
      return *(const bf16x8*)(p.kic + (size_t)(kb_row0 + key - 2048) * 32 + koff);
    }
    return *(const bf16x8*)(p.kic + (size_t)(kb_row0 + key) * 32 + koff);
  };

  if (L <= 256) {
    for (int i = tid; i < 8 * 256; i += 256) sel[i] = (u16)(i & 255);
    if (tid < 8) nval[tid] = L;
    __syncthreads();
  } else {
    bf16x8 qa[2][2], a2[2][2];
    {
      const int r = lane & 31; const int hh = (r >> 2) & 1; const int i = (r >> 3) * 4 + (r & 3);
      const int qit = 2 * hh + (i >> 3), head = i & 7;
#pragma unroll
      for (int T = 0; T < 2; ++T)
#pragma unroll
        for (int ks = 0; ks < 2; ++ks)
          qa[T][ks] = *(const bf16x8*)(p.proj + (size_t)(qrow0 + 4 * T + qit) * DPJ + C_QI + head * 32 + ks * 16 + (lane >> 5) * 8);
      const int kh = lane >> 5;
#pragma unroll
      for (int T = 0; T < 2; ++T)
#pragma unroll
        for (int ks = 0; ks < 2; ++ks) {
          bf16x8 v = (bf16x8){0, 0, 0, 0, 0, 0, 0, 0};
          if (r == (2 * T + ks) * 8 + 4 * kh) v = *(const bf16x8*)(p.proj + (size_t)(qrow0 + 4 * T + 2 * kh + ks) * DPJ + C_WI);
          a2[T][ks] = v;
        }
    }
#define LOADK(T_, K0, K1) { int key_ = (T_) * 32 + (lane & 31); int kc_ = key_ < L ? key_ : L - 1; K0 = ki_frag(kc_, (lane >> 5) * 8); K1 = ki_frag(kc_, 16 + (lane >> 5) * 8); }
    auto score_k = [&](bf16x8 kf0, bf16x8 kf1, float* sc) {
      __builtin_amdgcn_s_setprio(1);
      f32x16 accS;
#pragma unroll
      for (int i = 0; i < 16; ++i) accS[i] = 0.f;
#pragma unroll
      for (int T = 0; T < 2; ++T) {
        f32x16 acc;
#pragma unroll
        for (int i = 0; i < 16; ++i) acc[i] = 0.f;
        acc = mfma32(qa[T][0], kf0, acc); acc = mfma32(qa[T][1], kf1, acc);
#pragma unroll
        for (int ks = 0; ks < 2; ++ks) {
          uint4 b4;
          b4.x = pack2_relu(acc[8 * ks + 0], acc[8 * ks + 1]); b4.y = pack2_relu(acc[8 * ks + 2], acc[8 * ks + 3]);
          b4.z = pack2_relu(acc[8 * ks + 4], acc[8 * ks + 5]); b4.w = pack2_relu(acc[8 * ks + 6], acc[8 * ks + 7]);
          accS = mfma32(a2[T][ks], __builtin_bit_cast(bf16x8, b4), accS);
        }
      }
      sc[0] = accS[0]; sc[1] = accS[4]; sc[2] = accS[8]; sc[3] = accS[12];
      __builtin_amdgcn_s_setprio(0);
    };
    const int qbase = 2 * (lane >> 5);
    for (int i = tid; i < 8192 / 4; i += 256) ((uint4*)hist)[i] = make_uint4(0, 0, 0, 0);
    if (tid < 16) stats[tid] = 0.f;
    if (tid < 16) cnt[tid] = 0;
    __syncthreads();
    {
      float sm[4] = {0.f, 0.f, 0.f, 0.f}, sq[4] = {0.f, 0.f, 0.f, 0.f};
      bf16x8 a0, a1, b0, b1;
      LOADK(w, a0, a1); LOADK(w + 4, b0, b1);
      { float sc[4]; score_k(a0, a1, sc);
#pragma unroll
        for (int x = 0; x < 4; ++x) { sm[x] += sc[x]; sq[x] += sc[x] * sc[x]; } }
      { float sc[4]; score_k(b0, b1, sc);
#pragma unroll
        for (int x = 0; x < 4; ++x) { sm[x] += sc[x]; sq[x] += sc[x] * sc[x]; } }
#pragma unroll
      for (int x = 0; x < 4; ++x) {
#pragma unroll
        for (int o = 1; o < 32; o <<= 1) { sm[x] += __shfl_xor(sm[x], o); sq[x] += __shfl_xor(sq[x], o); }
      }
      if ((lane & 31) == 0) {
#pragma unroll
        for (int x = 0; x < 4; ++x) { int q = 4 * (x >> 1) + qbase + (x & 1); atomicAdd(&stats[q * 2], sm[x]); atomicAdd(&stats[q * 2 + 1], sq[x]); }
      }
    }
    __syncthreads();
    float mu[4], inv[4];
#pragma unroll
    for (int x = 0; x < 4; ++x) {
      int q = 4 * (x >> 1) + qbase + (x & 1);
      float m = stats[q * 2] * (1.f / 256.f);
      float var = stats[q * 2 + 1] * (1.f / 256.f) - m * m;
      mu[x] = m; inv[x] = 128.f * rsqrtf(fmaxf(var, 1e-20f));
    }
    const int ntiles = (L + 31) >> 5;
#define CLAMPT(T_) ((T_) < ntiles ? (T_) : ntiles - 1)
    {
      auto body1 = [&](bf16x8 k0, bf16x8 k1, int t) {
        float sc[4]; score_k(k0, k1, sc);
        if (t * 32 + (lane & 31) < L) {
#pragma unroll
          for (int x = 0; x < 4; ++x) {
            int q = 4 * (x >> 1) + qbase + (x & 1);
            int bin = (int)((sc[x] - mu[x]) * inv[x]) + 512; bin = bin < 0 ? 0 : (bin > 1023 ? 1023 : bin);
            atomicAdd(&hist[q * 1024 + bin], 1u);
          }
        }
      };
      bf16x8 a0, a1, b0, b1, c0, c1, d0, d1;
      LOADK(CLAMPT(w), a0, a1); LOADK(CLAMPT(w + 4), b0, b1); LOADK(CLAMPT(w + 8), c0, c1);
      for (int t = w; t < ntiles; t += 16) {
        LOADK(CLAMPT(t + 12), d0, d1); body1(a0, a1, t);
        if (t + 4 < ntiles) { LOADK(CLAMPT(t + 16), a0, a1); body1(b0, b1, t + 4); }
        if (t + 8 < ntiles) { LOADK(CLAMPT(t + 20), b0, b1); body1(c0, c1, t + 8); }
        if (t + 12 < ntiles) { LOADK(CLAMPT(t + 24), c0, c1); body1(d0, d1, t + 12); }
      }
    }
    __syncthreads();
    for (int qq = 0; qq < 2; ++qq) {
      const int q = 2 * w + qq;
      const uint4* hp = (const uint4*)(hist + q * 1024 + lane * 16);
      uint4 h0 = hp[0], h1 = hp[1], h2 = hp[2], h3 = hp[3];
      u32 hv[16] = {h0.x, h0.y, h0.z, h0.w, h1.x, h1.y, h1.z, h1.w, h2.x, h2.y, h2.z, h2.w, h3.x, h3.y, h3.z, h3.w};
      u32 tot = 0;
#pragma unroll
      for (int i = 0; i < 16; ++i) tot += hv[i];
      u32 incl = tot;
#pragma unroll
      for (int o = 1; o < 64; o <<= 1) { u32 v = __shfl_down(incl, o); if (lane + o < 64) incl += v; }
      unsigned long long bal = __ballot(incl >= 256u);
      const int Ls = 63 - __clzll(bal);
      if (lane == Ls) {
        u32 cum = incl - tot; int bstar = lane * 16; u32 nab = cum; bool found = false;
#pragma unroll
        for (int b = 15; b >= 0; --b) {
          if (!found) { if (cum + hv[b] >= 256u) { bstar = lane * 16 + b; nab = cum; found = true; } else cum += hv[b]; }
        }
        thr[q * 2] = bstar; thr[q * 2 + 1] = (int)nab;
      }
    }
    __syncthreads();
    int bst[4];
#pragma unroll
    for (int x = 0; x < 4; ++x) { int q = 4 * (x >> 1) + qbase + (x & 1); bst[x] = thr[q * 2]; }
    {
      auto body2 = [&](bf16x8 k0, bf16x8 k1, int t) {
        float sc[4]; score_k(k0, k1, sc);
        const int key = t * 32 + (lane & 31);
        if (key < L) {
#pragma unroll
          for (int x = 0; x < 4; ++x) {
            int q = 4 * (x >> 1) + qbase + (x & 1);
            int bin = (int)((sc[x] - mu[x]) * inv[x]) + 512; bin = bin < 0 ? 0 : (bin > 1023 ? 1023 : bin);
            if (bin > bst[x]) { u32 s_ = atomicAdd(&cnt[q * 2], 1u); if (s_ < 256u) sel[q * 256 + s_] = (u16)key; }
            else if (bin == bst[x]) { u32 s_ = atomicAdd(&cnt[q * 2 + 1], 1u); if (s_ < (u32)CANDC) { cand_s[q * CANDC + s_] = sc[x]; cand_i[q * CANDC + s_] = (u16)key; } }
          }
        }
      };
      bf16x8 a0, a1, b0, b1, c0, c1, d0, d1;
      LOADK(CLAMPT(w), a0, a1); LOADK(CLAMPT(w + 4), b0, b1); LOADK(CLAMPT(w + 8), c0, c1);
      for (int t = w; t < ntiles; t += 16) {
        LOADK(CLAMPT(t + 12), d0, d1); body2(a0, a1, t);
        if (t + 4 < ntiles) { LOADK(CLAMPT(t + 16), a0, a1); body2(b0, b1, t + 4); }
        if (t + 8 < ntiles) { LOADK(CLAMPT(t + 20), b0, b1); body2(c0, c1, t + 8); }
        if (t + 12 < ntiles) { LOADK(CLAMPT(t + 24), c0, c1); body2(d0, d1, t + 12); }
      }
    }
#undef CLAMPT
#undef LOADK
    __syncthreads();
    for (int qq = 0; qq < 2; ++qq) {
      const int q = 2 * w + qq;
      int m = (int)cnt[q * 2 + 1]; m = m > CANDC ? CANDC : m;
      const int nab = thr[q * 2 + 1];
      const int r = 256 - nab;
      for (int a = lane; a < m; a += 64) {
        const float sa = cand_s[q * CANDC + a]; const int ia = cand_i[q * CANDC + a];
        int rank = 0;
        for (int b = 0; b < m; ++b) {
          const float sbv = cand_s[q * CANDC + b]; const int ib = cand_i[q * CANDC + b];
          rank += ((sbv > sa) || (sbv == sa && ib < ia)) ? 1 : 0;
        }
        if (rank < r) sel[q * 256 + nab + rank] = (u16)ia;
      }
      if (lane == 0) nval[q] = nab + (r < m ? r : m);
    }
    __syncthreads();
  }

  float* Pbuf = (float*)smem + w * 2048;
  for (int qq = 0; qq < 2; ++qq) {
    const int q = 2 * w + qq;
    const int qrow = qrow0 + q;
    const int nv = nval[q];
    if (!SAMPLE) {
      typedef __attribute__((address_space(3))) unsigned lds_u32;
      typedef unsigned u32x2 __attribute__((ext_vector_type(2)));
      const int head = lane & 15;
      bf16x8 qf0, qf1;
      if (head < 6) {
        qf0 = *(const bf16x8*)(p.proj + (size_t)qrow * DPJ + C_QB + head * 64 + (lane >> 4) * 8);
        qf1 = *(const bf16x8*)(p.proj + (size_t)qrow * DPJ + C_QB + head * 64 + 32 + (lane >> 4) * 8);
      } else {
        qf0 = (bf16x8){0, 0, 0, 0, 0, 0, 0, 0}; qf1 = qf0;
      }
      f32x4 lgt[16];
#pragma unroll
      for (int kt = 0; kt < 16; ++kt) {
        const int slot = kt * 16 + (lane & 15);
        const int idx = slot < nv ? (int)sel[q * 256 + slot] : 0;
        const u16* kp = p.kc + (size_t)(kb_row0 + idx) * 64 + (lane >> 4) * 8;
        bf16x8 kf0 = *(const bf16x8*)kp, kf1 = *(const bf16x8*)(kp + 32);
        f32x4 acc = (f32x4){0.f, 0.f, 0.f, 0.f};
        acc = mfma16(kf0, qf0, acc); acc = mfma16(kf1, qf1, acc);
#pragma unroll
        for (int jj = 0; jj < 4; ++jj) lgt[kt][jj] = (kt * 16 + (lane >> 4) * 4 + jj) < nv ? acc[jj] * 0.125f : -INFINITY;
        if ((kt & 7) == 7) __builtin_amdgcn_sched_barrier(0);
      }
      float mx = -INFINITY;
#pragma unroll
      for (int kt = 0; kt < 16; ++kt)
#pragma unroll
        for (int jj = 0; jj < 4; ++jj) mx = fmaxf(mx, lgt[kt][jj]);
      mx = fmaxf(mx, __shfl_xor(mx, 16)); mx = fmaxf(mx, __shfl_xor(mx, 32));
      float sm = 0.f;
#pragma unroll
      for (int kt = 0; kt < 16; ++kt)
#pragma unroll
        for (int jj = 0; jj < 4; ++jj) { float e = __expf(lgt[kt][jj] - mx); lgt[kt][jj] = e; sm += e; }
      sm += __shfl_xor(sm, 16); sm += __shfl_xor(sm, 32);
      const float inv = 1.f / sm;
      unsigned char* Pw = smem + w * 3200;
      unsigned char* Vb0 = smem + 12800 + w * 4096;
      unsigned char* Vb1 = smem + 43264 + w * 4096;
      asm volatile("s_waitcnt vmcnt(0) lgkmcnt(0)" ::: "memory");
      if (head < 6) {
#pragma unroll
        for (int kt = 0; kt < 16; ++kt) {
          uint2 pk; pk.x = pack2(lgt[kt][0] * inv, lgt[kt][1] * inv); pk.y = pack2(lgt[kt][2] * inv, lgt[kt][3] * inv);
          *(uint2*)(Pw + head * 528 + (kt * 16 + (lane >> 4) * 4) * 2) = pk;
        }
      }
      const int drow = lane >> 3;
      const int dch0 = (((lane & 7) ^ (((lane >> 4) & 1) * 2)) << 3);
      const int dch1 = (((lane & 7) ^ (((lane >> 4) & 1) * 2 + 4)) << 3);
      bf16x8 af[8];
      int vidx[8][4];
#pragma unroll
      for (int ks = 0; ks < 8; ++ks) {
        af[ks] = (bf16x8){0, 0, 0, 0, 0, 0, 0, 0};
        if (head < 6) af[ks] = *(const bf16x8*)(Pw + head * 528 + (ks * 32 + (lane >> 4) * 8) * 2);
#pragma unroll
        for (int i = 0; i < 4; ++i) { const int slot_ = ks * 32 + i * 8 + drow; vidx[ks][i] = slot_ < nv ? (int)sel[q * 256 + slot_] : 0; }
      }
      asm volatile("s_waitcnt lgkmcnt(0)" ::: "memory");
#define PV_DMA(KS, BUF) { _Pragma("unroll") for (int i = 0; i < 4; ++i) { \
          __builtin_amdgcn_global_load_lds((const unsigned*)(p.vc + (size_t)(kb_row0 + vidx[KS][i]) * 64 + ((i & 1) ? dch1 : dch0)), (lds_u32*)((BUF) + i * 1024 + lane * 16), 16, 0, 0); } }
      const int tg = lane >> 4, tq = (lane & 15) >> 2, tp = lane & 3;
      const int trow = 8 * tg + tq, tf = ((tq >> 1) & 1) * 2 + (tg & 1) * 4;
      unsigned tad[4];
#pragma unroll
      for (int nt = 0; nt < 4; ++nt) tad[nt] = (unsigned)(trow * 128 + (((2 * nt + (tp >> 1)) ^ tf) << 4) + 8 * (tp & 1));
      const unsigned vb0a = (unsigned)(size_t)((__attribute__((address_space(3))) unsigned char*)Vb0);
      const unsigned vb1a = (unsigned)(size_t)((__attribute__((address_space(3))) unsigned char*)Vb1);
      f32x4 o[4];
#pragma unroll
      for (int nt = 0; nt < 4; ++nt) o[nt] = (f32x4){0.f, 0.f, 0.f, 0.f};
#define PV_STEP(KS, VBA) { u32x2 lo[4], hi[4]; \
        _Pragma("unroll") for (int nt = 0; nt < 4; ++nt) { \
          asm volatile("ds_read_b64_tr_b16 %0, %1" : "=v"(lo[nt]) : "v"((VBA) + tad[nt])); \
          asm volatile("ds_read_b64_tr_b16 %0, %1 offset:512" : "=v"(hi[nt]) : "v"((VBA) + tad[nt])); } \
        asm volatile("s_waitcnt lgkmcnt(0)" : "+v"(lo[0]), "+v"(lo[1]), "+v"(lo[2]), "+v"(lo[3]), "+v"(hi[0]), "+v"(hi[1]), "+v"(hi[2]), "+v"(hi[3]) :: "memory"); \
        _Pragma("unroll") for (int nt = 0; nt < 4; ++nt) { uint4 b4; b4.x = lo[nt].x; b4.y = lo[nt].y; b4.z = hi[nt].x; b4.w = hi[nt].y; \
          o[nt] = mfma16(af[KS], __builtin_bit_cast(bf16x8, b4), o[nt]); } }
      const int nks = (nv + 31) >> 5;
      PV_DMA(0, Vb0);
#pragma unroll
      for (int ks = 0; ks < 8; ks += 2) {
        if (ks < nks) {
          PV_DMA(ks + 1, Vb1);
          asm volatile("s_waitcnt vmcnt(4)" ::: "memory");
          PV_STEP(ks, vb0a);
          if (ks + 2 < nks) {
            if (ks + 2 < 8) PV_DMA((ks + 2 < 8 ? ks + 2 : 0), Vb0);
            asm volatile("s_waitcnt vmcnt(4)" ::: "memory");
          } else asm volatile("s_waitcnt vmcnt(0)" ::: "memory");
          PV_STEP(ks + 1, vb1a);
        }
      }
#undef PV_DMA
#undef PV_STEP
      if (lane < 32) {
#pragma unroll
        for (int nt = 0; nt < 4; ++nt)
#pragma unroll
          for (int jj = 0; jj < 4; ++jj) {
            const int hd = (lane >> 4) * 4 + jj;
            if (hd < 6) p.mix[(size_t)qrow * DM + 256 + hd * 64 + nt * 16 + (lane & 15)] = f2bf(o[nt][jj]);
          }
      }
    } else {
    const int head = lane & 15;
    bf16x8 qf0, qf1;
    if (head < 6) {
      qf0 = *(const bf16x8*)(p.proj + (size_t)qrow * DPJ + C_QB + head * 64 + (lane >> 4) * 8);
      qf1 = *(const bf16x8*)(p.proj + (size_t)qrow * DPJ + C_QB + head * 64 + 32 + (lane >> 4) * 8);
    } else {
      qf0 = (bf16x8){0, 0, 0, 0, 0, 0, 0, 0}; qf1 = qf0;
    }
    f32x4 lgt[16];
#pragma unroll
    for (int kt = 0; kt < 16; ++kt) {
      const int slot = kt * 16 + (lane & 15);
      const int idx = slot < nv ? (int)sel[q * 256 + slot] : 0;
      bf16x8 kf0, kf1;
      if (SAMPLE) {
        if (idx < 2048) {
          const float* f = p.cache_k + (((size_t)layer * 32 + sb) * 2048 + idx) * 64 + (lane >> 4) * 8;
          kf0 = pack8(((const float4*)f)[0], ((const float4*)f)[1]);
          kf1 = pack8(((const float4*)(f + 32))[0], ((const float4*)(f + 32))[1]);
        } else {
          const u16* kp = p.kc + (size_t)(kb_row0 + idx - 2048) * 64 + (lane >> 4) * 8;
          kf0 = *(const bf16x8*)kp; kf1 = *(const bf16x8*)(kp + 32);
        }
      } else {
        const u16* kp = p.kc + (size_t)(kb_row0 + idx) * 64 + (lane >> 4) * 8;
        kf0 = *(const bf16x8*)kp; kf1 = *(const bf16x8*)(kp + 32);
      }
      f32x4 acc = (f32x4){0.f, 0.f, 0.f, 0.f};
      acc = mfma16(qf0, kf0, acc); acc = mfma16(qf1, kf1, acc);
      const bool ok = slot < nv;
#pragma unroll
      for (int jj = 0; jj < 4; ++jj) lgt[kt][jj] = ok ? acc[jj] * 0.125f : -INFINITY;
      if ((kt & 7) == 7) __builtin_amdgcn_sched_barrier(0);
    }
    float inv_[4], mx_[4];
#pragma unroll
    for (int jj = 0; jj < 4; ++jj) {
      float mx = -INFINITY;
#pragma unroll
      for (int kt = 0; kt < 16; ++kt) mx = fmaxf(mx, lgt[kt][jj]);
#pragma unroll
      for (int o = 1; o < 16; o <<= 1) mx = fmaxf(mx, __shfl_xor(mx, o));
      float sm = 0.f;
#pragma unroll
      for (int kt = 0; kt < 16; ++kt) { float e = __expf(lgt[kt][jj] - mx); lgt[kt][jj] = e; sm += e; }
#pragma unroll
      for (int o = 1; o < 16; o <<= 1) sm += __shfl_xor(sm, o);
      inv_[jj] = 1.f / sm; mx_[jj] = mx;
    }
    asm volatile("s_waitcnt lgkmcnt(0)" ::: "memory");
    __builtin_amdgcn_wave_barrier();
    if (lane < 32) {
      const int hb = (lane >> 4) * 4;
#pragma unroll
      for (int kt = 0; kt < 16; ++kt) {
        const int slot = kt * 16 + (lane & 15);
        if (hb == 0) {
          *(float4*)(Pbuf + slot * 8) = make_float4(lgt[kt][0] * inv_[0], lgt[kt][1] * inv_[1], lgt[kt][2] * inv_[2], lgt[kt][3] * inv_[3]);
        } else {
          *(float2*)(Pbuf + slot * 8 + 4) = make_float2(lgt[kt][0] * inv_[0], lgt[kt][1] * inv_[1]);
        }
      }
    }
    asm volatile("s_waitcnt lgkmcnt(0)" ::: "memory");
    __builtin_amdgcn_wave_barrier();
    {
      typedef float f2v __attribute__((ext_vector_type(2)));
      const int sg = lane >> 3, dc = lane & 7;
      f2v o[6][4];
#pragma unroll
      for (int hh = 0; hh < 6; ++hh)
#pragma unroll
        for (int j = 0; j < 4; ++j) o[hh][j] = (f2v){0.f, 0.f};
      const int nit = (nv + 7) >> 3;
#pragma unroll 8
      for (int it = 0; it < nit; ++it) {
        const int slot = it * 8 + sg;
        const int idx = slot < nv ? (int)sel[q * 256 + slot] : 0;
        f2v vv[4];
        if (SAMPLE) {
          if (idx < 2048) {
            const float* vp = p.cache_v + (((size_t)layer * 32 + sb) * 2048 + idx) * 64 + dc * 8;
            float4 x0 = ((const float4*)vp)[0], x1 = ((const float4*)vp)[1];
            vv[0] = (f2v){x0.x, x0.y}; vv[1] = (f2v){x0.z, x0.w}; vv[2] = (f2v){x1.x, x1.y}; vv[3] = (f2v){x1.z, x1.w};
          } else {
            uint4 x = *(const uint4*)(p.vc + (size_t)(kb_row0 + idx - 2048) * 64 + dc * 8);
            vv[0] = (f2v){bflo(x.x), bfhi(x.x)}; vv[1] = (f2v){bflo(x.y), bfhi(x.y)}; vv[2] = (f2v){bflo(x.z), bfhi(x.z)}; vv[3] = (f2v){bflo(x.w), bfhi(x.w)};
          }
        } else {
          uint4 x = *(const uint4*)(p.vc + (size_t)(kb_row0 + idx) * 64 + dc * 8);
          vv[0] = (f2v){bflo(x.x), bfhi(x.x)}; vv[1] = (f2v){bflo(x.y), bfhi(x.y)}; vv[2] = (f2v){bflo(x.z), bfhi(x.z)}; vv[3] = (f2v){bflo(x.w), bfhi(x.w)};
        }
        float4 pa = *(const float4*)(Pbuf + slot * 8);
        float2 pb = *(const float2*)(Pbuf + slot * 8 + 4);
        const float ph_[6] = {pa.x, pa.y, pa.z, pa.w, pb.x, pb.y};
#pragma unroll
        for (int hh = 0; hh < 6; ++hh) {
          const f2v pp = (f2v){ph_[hh], ph_[hh]};
#pragma unroll
          for (int j = 0; j < 4; ++j) o[hh][j] = pp * vv[j] + o[hh][j];
        }
      }
#pragma unroll
      for (int hh = 0; hh < 6; ++hh) {
#pragma unroll
        for (int j = 0; j < 4; ++j) {
#pragma unroll
          for (int m = 8; m < 64; m <<= 1) { o[hh][j].x += __shfl_xor(o[hh][j].x, m); o[hh][j].y += __shfl_xor(o[hh][j].y, m); }
        }
        if (lane < 8) {
          uint4 r4; r4.x = pack2(o[hh][0].x, o[hh][0].y); r4.y = pack2(o[hh][1].x, o[hh][1].y); r4.z = pack2(o[hh][2].x, o[hh][2].y); r4.w = pack2(o[hh][3].x, o[hh][3].y);
          *(uint4*)(p.mix + (size_t)qrow * DM + 256 + hh * 64 + dc * 8) = r4;
        }
      }
    }
    }
  }
  __syncthreads();
}

constexpr int NT_KV = 1536 + 192, NT_MA = 512 + 128, NT_DS = 64, NT_DP = 2048;

#define WQ_BASE 3520
#define WQ_WORDS 3712
__device__ __forceinline__ int wq_next(unsigned* ctr, int* s_task) {
  __syncthreads();
  if (threadIdx.x == 0) *s_task = (int)atomicAdd(ctr, 1u);
  __syncthreads();
  return *s_task;
}
#define WQ_LOOP(CTR, N, VAR, ...) { int VAR = wq_next(CTR, s_task); while (VAR < (N)) { \
    if (threadIdx.x == 0) s_task[1] = (int)atomicAdd(CTR, 1u); \
    __VA_ARGS__; \
    VAR = s_task[1]; __syncthreads(); } }
__device__ __forceinline__ void mix1_phase(const P& p, int layer, unsigned char* smem, const int sub, int* s_task) {
  unsigned* ctr = p.bar + WQ_BASE + layer * 64;
  if (sub & 4) WQ_LOOP(ctr, NT_DS, s, { int sb = s >> 1, sb2 = s & 1;
    dsa_task<true>(p, layer, NPR + sb * 16 + sb2 * 8, NPR + sb * 16, sb, 2064, smem); })
  if (sub & 8) WQ_LOOP(ctr + 16, NT_DP, d, { int c = 127 - (d >> 4); int bb = (d >> 3) & 1; int sb2 = d & 7;
    dsa_task<false>(p, layer, bb * 8192 + c * 64 + sb2 * 8, bb * 8192, 0, (c + 1) * 64, smem); })
  if (sub & 2) WQ_LOOP(ctr + 32, NT_MA, t, { mixer_a_task(p, layer, t, smem); })
  if (sub & 1) WQ_LOOP(ctr + 48, NT_KV, t, { ret_kv_task(p, layer, t, smem); })
}
#undef WQ_LOOP

constexpr int NPHASE = 1 + 2 * 13;

__device__ __forceinline__ void run_phase(const P& p, int ph, unsigned char* smem, const bool dry, int* s_task) {
  if (ph == 0) { prep_phase(p, smem); return; }
  const int layer = (ph - 1) / 13, k = (ph - 1) % 13;
  if (k == 0 || k == 4 || k == 6 || k == 9 || k == 8 || k == 10 || k == 11) {
    int epi, NTN, mtiles, mt_base = 0, slab = -1, lda, K; const u16 *A, *Bt;
    if (k == 0) { epi = EPI_IN; NTN = DPJP / 128; mtiles = NR / 128; A = p.xb; lda = DM; K = DM; Bt = p.WinT + (size_t)layer * DPJP * DM; }
    else if (k == 4) { epi = EPI_OUT; NTN = 8; mtiles = NR / 128; A = p.mix; lda = DM; K = DM; Bt = p.WoutT + (size_t)layer * DM * DM; }
    else if (k == 6 || k == 9) { epi = EPI_GU; NTN = 44; slab = (k == 6) ? 0 : 1; mtiles = (k == 6) ? 68 : 64; A = p.xb; lda = DM; K = DM; Bt = p.WguT + (size_t)layer * 2 * DFF * DM; }
    else { epi = EPI_DOWN; NTN = 8; slab = (k == 11) ? 1 : 0; mtiles = (k == 10) ? 4 : 64; mt_base = (k == 10) ? 64 : 0; A = p.hu; lda = DFF; K = DFF; Bt = p.WdT + (size_t)layer * DM * DFF; }
    const int xcd = blockIdx.x & 7, jloc = blockIdx.x >> 3, nloc = gridDim.x >> 3;
    const int T = mtiles * NTN;
    const int u0 = (int)(((long)T * xcd) >> 3), u1 = (int)(((long)T * (xcd + 1)) >> 3);
    for (int u = u0 + jloc; u < u1; u += nloc) {
      const int sr = u / (8 * NTN);
      const int v = u - sr * 8 * NTN;
      const int Mr = (mtiles - sr * 8) < 8 ? (mtiles - sr * 8) : 8;
      const int nt = v / Mr, mi = v - nt * Mr;
      const int mtl = mt_base + sr * 8 + mi;
      const int hrow0 = mtl * 128;
      const int grow0 = (slab == 0) ? (mtl < 64 ? hrow0 : NPR + (mtl - 64) * 128) : (slab == 1 ? 8192 + hrow0 : hrow0);
      const u16* At = (epi == EPI_DOWN) ? A + (size_t)hrow0 * lda : A + (size_t)grow0 * lda;
      gemm_tile(p, epi, layer, grow0 - hrow0, At, lda, Bt + (size_t)nt * 128 * K, K, K, grow0, nt * 128, smem, dry);
    }
    if (k == 10) act_phase(p, layer, 1, 8192, dry, 32);
    return;
  }
  switch (k) {
    case 1: mix1_phase(p, layer, smem, 15, s_task); break;
    case 2: scan_phase(p, layer, dry);
      if (!dry && gridDim.x > 192) for (int t = 1536 + ((int)blockIdx.x - 192); t >= 1536 && t < NT_KV; t += gridDim.x - 192) ret_out_task(p, layer, t, smem);
      break;
    case 3: for (int t = blockIdx.x; t < (gridDim.x > 192 ? 1536 : NT_KV); t += gridDim.x) ret_out_task(p, layer, t, smem); break;
    case 5: ln_phase(p, p.ln1_g + layer * DM, p.ln1_b + layer * DM, dry, false, true, p.zb1); break;
    case 7: act_phase(p, layer, 0, 8704, dry, 0); break;
    case 12: ln_phase(p, p.ln2_g + layer * DM, p.ln2_b + layer * DM, dry, layer == 1, layer == 0, p.zb2); break;
  }
}

__global__ void __launch_bounds__(256, 2) mega(P p, int ph0, int ph1, int dryflag) {
  __shared__ __attribute__((aligned(16))) unsigned char smem[73728];
  __shared__ uint4 xb_words;
  __shared__ int s_task[2];
  if (threadIdx.x == 0) xb_words = make_uint4(0u, 0u, 0u, 0u);
  __syncthreads();
  XcdBarrier xb = xcd_barrier_post(p.bar, (volatile LAS unsigned*)&xb_words);
  if (ph1 < 0) cg::this_grid().sync();
  for (int ph = ph0; ph < ph1; ++ph) {
    run_phase(p, ph, smem, false, s_task);
#if PROBE_MASK
    if (ph > 0 && ((PROBE_MASK >> ((ph - 1) % 13)) & 1)) run_phase(p, ph, smem, dryflag != 0, s_task);
    if (ph > 0 && ((ph - 1) % 13) == 1 && (PROBE_MASK >> 13)) mix1_phase(p, (ph - 1) / 13, smem, (PROBE_MASK >> 13) & (14 + dryflag), s_task);
#endif
    if (ph + 1 < ph1) xcd_barrier(xb);
  }
}

extern "C" void kernel_launch(void* const* d_in, const int* in_sizes, int n_in, void* d_out, int out_size, void* d_ws,
                              size_t ws_size, hipStream_t stream) {
  P p{};
  p.x_prompt = (const float*)d_in[0]; p.x_sample = (const float*)d_in[1]; p.cache_k = (const float*)d_in[2];
  p.cache_v = (const float*)d_in[3]; p.cache_ki = (const float*)d_in[4]; p.state_ret = (const float*)d_in[5];
  p.state_conv = (const float*)d_in[6]; p.w_in = (const float*)d_in[7]; p.a_ln_g = (const float*)d_in[8];
  p.a_ln_b = (const float*)d_in[9]; p.a_ws = (const float*)d_in[10]; p.a_bs = (const float*)d_in[11];
  p.c_gn_g = (const float*)d_in[12]; p.w_out = (const float*)d_in[13]; p.ln1_g = (const float*)d_in[14];
  p.ln1_b = (const float*)d_in[15]; p.w_gate = (const float*)d_in[16]; p.w_up = (const float*)d_in[17];
  p.conv_w = (const float*)d_in[18]; p.conv_b = (const float*)d_in[19]; p.w_down = (const float*)d_in[20];
  p.ln2_g = (const float*)d_in[21]; p.ln2_b = (const float*)d_in[22];
  p.out = (float*)d_out;
  unsigned char* ws = (unsigned char*)d_ws;
  size_t o = 0;
  p.WinT = (u16*)(ws + o);  o += 2ull * DPJP * DM * 2;
  p.WoutT = (u16*)(ws + o); o += 2ull * DM * DM * 2;
  p.WguT = (u16*)(ws + o);  o += 2ull * 2 * DFF * DM * 2;
  p.WdT = (u16*)(ws + o);   o += 2ull * DM * DFF * 2;
  p.rope = (float*)(ws + o); o += 8192ull * 32 * 2 * 4;
  p.xb = (u16*)(ws + o);    o += (size_t)NR * DM * 2;
  unsigned char* big = ws + o;
  p.proj = (u16*)big;
  p.mix = (u16*)(big + (size_t)NR * DPJ * 2);
  p.kvbuf = (float*)(big + (size_t)NR * DPJ * 2 + (size_t)NR * DM * 2);
  p.hg = (u16*)big;
  p.hu = (u16*)(big + 8704ull * DFF * 2);
  p.zb1 = (u16*)big;
  p.zb2 = (u16*)(big + (100ull << 20));
  p.bar = (unsigned*)(ws + (250ull << 20));
  p.kic = (u16*)(ws + (233ull << 20)); p.kc = (u16*)(ws + (235ull << 20)); p.vc = (u16*)(ws + (238ull << 20));
  hipMemsetAsync(p.bar, 0, WQ_WORDS * 4, stream);

  static int grid_blocks = 0;
  if (!grid_blocks) {
    int dev = 0, cus = 0, per_cu = 0;
    hipGetDevice(&dev);
    hipDeviceGetAttribute(&cus, hipDeviceAttributeMultiprocessorCount, dev);
    hipOccupancyMaxActiveBlocksPerMultiprocessor(&per_cu, mega, 256, 0);
    if (per_cu > 2) per_cu = 2;
    if (per_cu < 1) per_cu = 1;
    grid_blocks = cus * per_cu;
  }
#if MULTI
  for (int ph = 0; ph < NPHASE; ++ph) {
    hipLaunchKernelGGL(mega, dim3(grid_blocks), dim3(256), 0, stream, p, ph, ph + 1, 1);
  }
#else
  int ph0 = 0, ph1 = NPHASE, dryflag = 1;
  void* args[] = {&p, &ph0, &ph1, &dryflag};
  hipError_t e = hipLaunchCooperativeKernel((void*)mega, dim3(grid_blocks), dim3(256), args, 0, stream);
  if (e != hipSuccess) fprintf(stderr, "cooperative launch failed: %s (grid %d)\n", hipGetErrorString(e), grid_blocks);
#endif
}
```

```cpp
#include <hip/hip_runtime.h>
#include <hip/hip_cooperative_groups.h>
#include <cstdio>
namespace cg = cooperative_groups;

#ifndef MULTI
#define MULTI 0
#endif
#ifndef PROBE_MASK
#define PROBE_MASK 0
#endif

typedef unsigned short u16;
typedef unsigned int u32;
typedef __attribute__((ext_vector_type(8))) short bf16x8;
typedef __attribute__((ext_vector_type(4))) float f32x4;
typedef __attribute__((ext_vector_type(16))) float f32x16;

constexpr int NPR = 16384, NSR = 512, NR = 16896;
constexpr int DM = 1024, DPJ = 2856, DPJP = 2944, DFF = 2816;
constexpr int C_UA = 0, C_VA = 256, C_QB = 512, C_KB = 896, C_VB = 960, C_QI = 1024, C_KI = 1280,
              C_WI = 1312, C_QC = 1320, C_KC = 1704, C_VC = 2088, C_GC = 2472;
constexpr float ALPHA = 1.4142135623730951f;

constexpr size_t OFF_Y   = 0;
constexpr size_t OFF_KP  = (size_t)NR * DM;
constexpr size_t OFF_VP  = OFF_KP + 2ull * 2 * 8192 * 64;
constexpr size_t OFF_KIP = OFF_VP + 2ull * 2 * 8192 * 64;
constexpr size_t OFF_RP  = OFF_KIP + 2ull * 2 * 8192 * 32;
constexpr size_t OFF_CP  = OFF_RP + 2ull * 2 * 6 * 4096;
constexpr size_t OFF_KS  = OFF_CP + 2ull * 2 * 2 * DFF;
constexpr size_t OFF_VS  = OFF_KS + 2ull * 32 * 16 * 64;
constexpr size_t OFF_KIS = OFF_VS + 2ull * 32 * 16 * 64;
constexpr size_t OFF_RS  = OFF_KIS + 2ull * 32 * 16 * 32;
constexpr size_t OFF_CS  = OFF_RS + 2ull * 32 * 6 * 4096;
constexpr size_t OFF_AV  = OFF_CS + 2ull * 32 * 2 * DFF;

struct P {
  const float *x_prompt, *x_sample, *cache_k, *cache_v, *cache_ki, *state_ret, *state_conv;
  const float *w_in, *a_ln_g, *a_ln_b, *a_ws, *a_bs, *c_gn_g, *w_out, *ln1_g, *ln1_b;
  const float *w_gate, *w_up, *conv_w, *conv_b, *w_down, *ln2_g, *ln2_b;
  float* out;
  u16 *WinT, *WoutT, *WguT, *WdT, *xb, *proj, *mix, *hg, *hu;
  float *rope, *kvbuf;
  unsigned* bar;
  u16 *kic, *kc, *vc;
  u16 *zb1, *zb2;
};

__constant__ double FREQ_REV[32] = {
0.15915494309189535, 0.11934937021124886, 0.08949940160889101, 0.06711508300522726, 0.050329212104487035, 0.03774158471741977, 0.0283021958306234, 0.02122365276477766, 0.015915494309189534, 0.011934937021124886, 0.008949940160889102, 0.006711508300522725, 0.005032921210448704, 0.003774158471741977, 0.00283021958306234, 0.0021223652764777662, 0.0015915494309189536, 0.0011934937021124885, 0.0008949940160889102, 0.0006711508300522726, 0.0005032921210448703, 0.00037741584717419774, 0.00028302195830623395, 0.0002122365276477766, 0.00015915494309189535, 0.00011934937021124886, 8.949940160889102e-05, 6.711508300522725e-05, 5.0329212104487035e-05, 3.774158471741978e-05, 2.8302195830623396e-05, 2.122365276477766e-05};

__device__ __forceinline__ u16 f2bf(float f) { __bf16 h = (__bf16)f; return __builtin_bit_cast(u16, h); }
__device__ __forceinline__ float bf2f(u32 h) { return __uint_as_float(h << 16); }
typedef __bf16 bf2_t __attribute__((ext_vector_type(2)));
typedef float fl2_t __attribute__((ext_vector_type(2)));
typedef short s2_t __attribute__((ext_vector_type(2)));
__device__ __forceinline__ u32 pack2(float a, float b) { fl2_t f = {a, b}; bf2_t h = __builtin_convertvector(f, bf2_t); return __builtin_bit_cast(u32, h); }
__device__ __forceinline__ u32 pack2_relu(float a, float b) { u32 v = pack2(a, b); s2_t s = __builtin_bit_cast(s2_t, v); s2_t z = {0, 0}; s = __builtin_elementwise_max(s, z); return __builtin_bit_cast(u32, s); }
__device__ __forceinline__ float bflo(u32 w) { return __uint_as_float(w << 16); }
__device__ __forceinline__ float bfhi(u32 w) { return __uint_as_float(w & 0xffff0000u); }
__device__ __forceinline__ float gelu_f(float x) { float t = 1.5957691216f * (x + 0.044715f * x * x * x); return x / (1.f + __expf(-t)); }
__device__ __forceinline__ float silu_f(float x) { return x / (1.f + __expf(-x)); }
__device__ __forceinline__ bf16x8 pack8(float4 a, float4 b) {
  uint4 r; r.x = pack2(a.x, a.y); r.y = pack2(a.z, a.w); r.z = pack2(b.x, b.y); r.w = pack2(b.z, b.w);
  return __builtin_bit_cast(bf16x8, r);
}
__device__ __forceinline__ f32x4 mfma16(bf16x8 a, bf16x8 b, f32x4 c) { return __builtin_amdgcn_mfma_f32_16x16x32_bf16(a, b, c, 0, 0, 0); }
__device__ __forceinline__ f32x16 mfma32(bf16x8 a, bf16x8 b, f32x16 c) { return __builtin_amdgcn_mfma_f32_32x32x16_bf16(a, b, c, 0, 0, 0); }
__device__ __forceinline__ int TID() { int t = threadIdx.x; asm volatile("" : "+v"(t)); return t; }
__device__ __forceinline__ float head_lg(int h) { return logf(1.0f - exp2f(-5.0f - (float)h)); }


#define XB_TMO      128
#define XB_XCNT(j)  (256  + 64 * (j))
#define XB_XSUB(j)  (1280 + 64 * (j))
#define XB_XGEN(j)  (2304 + 64 * (j))
#define XB_TOP      3328
#define XB_TOPGEN   3392
#define XCD_BAR_WORDS 3456
#define XB_SPIN_CAP (1u << 22)
#define LAS __attribute__((address_space(3)))
__device__ __forceinline__ unsigned xb_ld(unsigned* p)              { return __hip_atomic_load(p, __ATOMIC_RELAXED, __HIP_MEMORY_SCOPE_AGENT); }
__device__ __forceinline__ unsigned xb_add(unsigned* p, unsigned v) { return __hip_atomic_fetch_add(p, v, __ATOMIC_RELAXED, __HIP_MEMORY_SCOPE_AGENT); }
__device__ __forceinline__ unsigned xb_xcc_id() { return (unsigned)__builtin_amdgcn_s_getreg((3 << 11) | 20) & 0xFu; }
#define XB_SPIN(cond, bar) do { unsigned _sp = 0; while (cond) { __builtin_amdgcn_s_sleep(1); \
    if ((++_sp & 255u) == 0u) { if (xb_ld(&(bar)[XB_TMO])) break; if (_sp > XB_SPIN_CAP) { atomicAdd(&(bar)[XB_TMO], 1u); break; } } } } while (0)
struct XcdBarrier { unsigned* bar; unsigned x; volatile LAS unsigned* st; };
__device__ __forceinline__ XcdBarrier xcd_barrier_post(unsigned* bar, volatile LAS unsigned* st) {
    XcdBarrier b; b.bar = bar; b.x = xb_xcc_id(); b.st = st;
    if (threadIdx.x == 0) (void)xb_add(&bar[XB_XCNT(b.x)], 1u);
    return b;
}
__device__ __forceinline__ void xcd_barrier_complete(unsigned* bar, unsigned x, unsigned& nloc, unsigned& nx) {
    const unsigned G = gridDim.x * gridDim.y * gridDim.z;
    unsigned sum, cnt, mine, sp = 0u;
    for (;;) {
        sum = 0u; cnt = 0u; mine = 0u;
#pragma unroll
        for (unsigned j = 0; j < 16; ++j) { const unsigned c = xb_ld(&bar[XB_XCNT(j)]); sum += c; cnt += (c > 0u) ? 1u : 0u; mine = (j == x) ? c : mine; }
        if (sum == G) break;
        __builtin_amdgcn_s_sleep(1);
        if ((++sp & 255u) == 0u) { if (xb_ld(&bar[XB_TMO])) break; if (sp > XB_SPIN_CAP) { atomicAdd(&bar[XB_TMO], 1u); break; } }
    }
    nloc = mine > 0u ? mine : 1u; nx = cnt > 0u ? cnt : 1u;
}
__device__ __forceinline__ void xcd_barrier(const XcdBarrier& b) {
    asm volatile("s_waitcnt vmcnt(0)" ::: "memory");
    __syncthreads();
    if (threadIdx.x == 0) {
        unsigned* bar = b.bar;
        __builtin_amdgcn_s_waitcnt(0);
        unsigned nloc = b.st[0], nx = b.st[1];
        if (nloc == 0u) { xcd_barrier_complete(bar, b.x, nloc, nx); b.st[0] = nloc; b.st[1] = nx; }
        const unsigned old = xb_add(&bar[XB_XSUB(b.x)], 1u);
        const unsigned gen = old / nloc;
        if (old + 1u == (gen + 1u) * nloc) {
            __builtin_amdgcn_fence(__ATOMIC_RELEASE, "agent");
            asm volatile("s_waitcnt vmcnt(0)" ::: "memory");
            const unsigned og = xb_add(&bar[XB_TOP], 1u);
            const unsigned tg = og / nx;
            if (og + 1u == (tg + 1u) * nx) xb_add(&bar[XB_TOPGEN], 1u);
            else XB_SPIN(xb_ld(&bar[XB_TOPGEN]) == tg, bar);
            __builtin_amdgcn_fence(__ATOMIC_ACQUIRE, "agent");
            xb_add(&bar[XB_XGEN(b.x)], 1u);
            asm volatile("s_waitcnt vmcnt(0)" ::: "memory");
        } else {
            XB_SPIN(xb_ld(&bar[XB_XGEN(b.x)]) == gen, bar);
            __builtin_amdgcn_fence(__ATOMIC_ACQUIRE, "agent");
            asm volatile("s_waitcnt vmcnt(0)" ::: "memory");
        }
    }
    __syncthreads();
}

__device__ __forceinline__ void transpose_tile(const float* __restrict__ W, int K, int N, u16* __restrict__ Wt, int k0, int n0, float* tile) {
  const int tid = TID();
#pragma unroll
  for (int i = 0; i < 4; ++i) {
    int idx = tid + i * 256; int kr = idx >> 4, c4 = (idx & 15) * 4; int n = n0 + c4;
    float4 v = make_float4(0.f, 0.f, 0.f, 0.f);
    if (n < N) v = *(const float4*)(W + (size_t)(k0 + kr) * N + n);
    float* t = tile + kr * 65 + c4; t[0] = v.x; t[1] = v.y; t[2] = v.z; t[3] = v.w;
  }
  __syncthreads();
#pragma unroll
  for (int i = 0; i < 2; ++i) {
    int idx = tid + i * 256; int j = idx >> 3, c = (idx & 7) * 8;
    uint4 r;
    r.x = pack2(tile[(c + 0) * 65 + j], tile[(c + 1) * 65 + j]);
    r.y = pack2(tile[(c + 2) * 65 + j], tile[(c + 3) * 65 + j]);
    r.z = pack2(tile[(c + 4) * 65 + j], tile[(c + 5) * 65 + j]);
    r.w = pack2(tile[(c + 6) * 65 + j], tile[(c + 7) * 65 + j]);
    *(uint4*)(Wt + (size_t)(n0 + j) * K + k0 + c) = r;
  }
  __syncthreads();
}

__device__ __forceinline__ void tt_load(const float* __restrict__ W, int N, int k0, int n0, int tid, float4* v) {
#pragma unroll
  for (int i = 0; i < 4; ++i) {
    int idx = tid + i * 256; int kr = idx >> 4, c4 = (idx & 15) * 4; int n = n0 + c4;
    v[i] = make_float4(0.f, 0.f, 0.f, 0.f);
    if (n < N) v[i] = *(const float4*)(W + (size_t)(k0 + kr) * N + n);
  }
}
__device__ __forceinline__ void tt_lds(const float4* v, int tid, float* tile) {
#pragma unroll
  for (int i = 0; i < 4; ++i) {
    int idx = tid + i * 256; int kr = idx >> 4, c4 = (idx & 15) * 4;
    float* t = tile + kr * 65 + c4; t[0] = v[i].x; t[1] = v[i].y; t[2] = v[i].z; t[3] = v[i].w;
  }
}
__device__ __forceinline__ void tt_out(u16* __restrict__ Wt, int K, int k0, int n0, int tid, const float* tile) {
#pragma unroll
  for (int i = 0; i < 2; ++i) {
    int idx = tid + i * 256; int j = idx >> 3, c = (idx & 7) * 8;
    uint4 r;
    r.x = pack2(tile[(c + 0) * 65 + j], tile[(c + 1) * 65 + j]);
    r.y = pack2(tile[(c + 2) * 65 + j], tile[(c + 3) * 65 + j]);
    r.z = pack2(tile[(c + 4) * 65 + j], tile[(c + 5) * 65 + j]);
    r.w = pack2(tile[(c + 6) * 65 + j], tile[(c + 7) * 65 + j]);
    *(uint4*)(Wt + (size_t)(n0 + j) * K + k0 + c) = r;
  }
}
struct TDesc { const float* W; u16* Wt; int K, N, k0, n0; };
__device__ __forceinline__ TDesc tt_decode(const P& p, int t);

constexpr int PT_WIN = 16 * 46, PT_WOUT = 256, PT_WG = 16 * 44, PT_WD = 44 * 16;
constexpr int PT_LAYER = PT_WIN + PT_WOUT + 2 * PT_WG + PT_WD;
constexpr int PT_X = NR * DM / 8192;
constexpr int PT_ROPE = 256;
constexpr int PT_TOTAL = 2 * PT_LAYER + PT_X + PT_ROPE;

__device__ __forceinline__ TDesc tt_decode(const P& p, int t) {
  TDesc d;
  int l = t / PT_LAYER, u = t % PT_LAYER;
  if (u < PT_WIN) { d.W = p.w_in + (size_t)l * DM * DPJ; d.K = DM; d.N = DPJ; d.Wt = p.WinT + (size_t)l * DPJP * DM; d.k0 = (u / 46) * 64; d.n0 = (u % 46) * 64; }
  else if ((u -= PT_WIN) < PT_WOUT) { d.W = p.w_out + (size_t)l * DM * DM; d.K = DM; d.N = DM; d.Wt = p.WoutT + (size_t)l * DM * DM; d.k0 = (u / 16) * 64; d.n0 = (u % 16) * 64; }
  else if ((u -= PT_WOUT) < PT_WG) { d.W = p.w_gate + (size_t)l * DM * DFF; d.K = DM; d.N = DFF; d.Wt = p.WguT + (size_t)l * 2 * DFF * DM; d.k0 = (u / 44) * 64; d.n0 = (u % 44) * 64; }
  else if ((u -= PT_WG) < PT_WG) { d.W = p.w_up + (size_t)l * DM * DFF; d.K = DM; d.N = DFF; d.Wt = p.WguT + (size_t)l * 2 * DFF * DM + (size_t)DFF * DM; d.k0 = (u / 44) * 64; d.n0 = (u % 44) * 64; }
  else { u -= PT_WG; d.W = p.w_down + (size_t)l * DFF * DM; d.K = DFF; d.N = DM; d.Wt = p.WdT + (size_t)l * DM * DFF; d.k0 = (u / 16) * 64; d.n0 = (u % 16) * 64; }
  return d;
}
__device__ __forceinline__ void prep_phase(const P& p, unsigned char* smem) {
  float* tile = (float*)smem;
  const int tid = TID();
  float* tile2 = tile + 64 * 65;
  for (int t = blockIdx.x; t < 2 * PT_LAYER; t += 2 * gridDim.x) {
    const TDesc a = tt_decode(p, t);
    const int t2 = t + gridDim.x;
    const bool hb = t2 < 2 * PT_LAYER;
    const TDesc b = tt_decode(p, hb ? t2 : t);
    float4 va[4], vb[4];
    tt_load(a.W, a.N, a.k0, a.n0, tid, va);
    if (hb) tt_load(b.W, b.N, b.k0, b.n0, tid, vb);
    tt_lds(va, tid, tile);
    if (hb) tt_lds(vb, tid, tile2);
    __syncthreads();
    tt_out(a.Wt, a.K, a.k0, a.n0, tid, tile);
    if (hb) tt_out(b.Wt, b.K, b.k0, b.n0, tid, tile2);
    __syncthreads();
  }
  for (int t = 2 * PT_LAYER + blockIdx.x; t < PT_TOTAL; t += gridDim.x) {
    if (false) {
    } else if (t < 2 * PT_LAYER + PT_X) {
      int u = t - 2 * PT_LAYER;
#pragma unroll
      for (int i = 0; i < 4; ++i) {
        size_t idx = ((size_t)u * 1024 + i * 256 + tid) * 8;
        const float* src = idx < (size_t)NPR * DM ? p.x_prompt + idx : p.x_sample + (idx - (size_t)NPR * DM);
        float4 a = ((const float4*)src)[0], b = ((const float4*)src)[1];
        *(bf16x8*)(p.xb + idx) = pack8(a, b);
      }
    } else {
      int u = t - 2 * PT_LAYER - PT_X;
#pragma unroll
      for (int i = 0; i < 4; ++i) {
        int e = u * 1024 + i * 256 + tid; int pos = e >> 5, ii = e & 31;
        double rev = (double)pos * FREQ_REV[ii];
        rev -= floor(rev);
        float fr = (float)rev;
        float2 cs; cs.x = __builtin_amdgcn_cosf(fr); cs.y = __builtin_amdgcn_sinf(fr);
        *(float2*)(p.rope + (size_t)e * 2) = cs;
      }
    }
  }
}

enum { EPI_IN = 0, EPI_OUT = 1, EPI_GU = 2, EPI_DOWN = 3 };

__device__ __forceinline__ void gemm_tile(const P& p, const int EPI, int layer, int slab_row0, const u16* __restrict__ Atile, int lda,
                                          const u16* __restrict__ Btile, int ldb, int K, int m0, int n0, unsigned char* smem, const bool dry) {
  const int tid = TID(), lane = tid & 63, wid = tid >> 6;
  const int wr = wid >> 1, wc = wid & 1;
  const int grow = tid >> 3, gcol = (((tid & 7) ^ ((tid >> 4) & 7)) << 3);
  const u16* ap = Atile + (size_t)grow * lda + gcol;
  const u16* bp = Btile + (size_t)grow * ldb + gcol;
  f32x4 acc[4][4];
#pragma unroll
  for (int i = 0; i < 4; ++i)
#pragma unroll
    for (int j = 0; j < 4; ++j) acc[i][j] = (f32x4){0.f, 0.f, 0.f, 0.f};
  const int nk = K >> 6;
  const int swr = (lane & 15) >> 1, q4 = lane >> 4;
  const int aoff = (wr * 64 + (lane & 15)) * 128 + ((q4 ^ swr) << 4);
  const int boff = 16384 + (wc * 64 + (lane & 15)) * 128 + ((q4 ^ swr) << 4);
  typedef __attribute__((address_space(3))) unsigned lds_u32;
#define G_DMA1(I, KT, ST) __builtin_amdgcn_global_load_lds((const unsigned*)(ap + (size_t)I * 32 * lda + (KT) * 64), (lds_u32*)(smem + (ST) * 32768 + I * 4096 + tid * 16), 16, 0, 0); \
                          __builtin_amdgcn_global_load_lds((const unsigned*)(bp + (size_t)I * 32 * ldb + (KT) * 64), (lds_u32*)(smem + (ST) * 32768 + 16384 + I * 4096 + tid * 16), 16, 0, 0);
#define G_DMA(KT, ST) { G_DMA1(0, KT, ST) G_DMA1(1, KT, ST) G_DMA1(2, KT, ST) G_DMA1(3, KT, ST) }
  const unsigned lbase = (unsigned)(size_t)((__attribute__((address_space(3))) unsigned char*)smem);
  const unsigned aad0 = lbase + aoff, aad1 = lbase + (aoff ^ 64), bad0 = lbase + boff, bad1 = lbase + (boff ^ 64);
#define LDSR(DST, ADDR, OFF) asm volatile("ds_read_b128 %0, %1 offset:%2" : "=v"(DST) : "v"(ADDR), "n"(OFF))
#define LWAIT8(A, B) asm volatile("s_waitcnt lgkmcnt(0)" : "+v"(A[0]), "+v"(A[1]), "+v"(A[2]), "+v"(A[3]), "+v"(B[0]), "+v"(B[1]), "+v"(B[2]), "+v"(B[3]) :: "memory")
#define G_COMPUTE(BUF) { bf16x8 af0[4], bf0[4], af1[4], bf1[4]; \
      LDSR(af0[0], aad0, (BUF) * 32768 + 0); LDSR(af0[1], aad0, (BUF) * 32768 + 2048); LDSR(af0[2], aad0, (BUF) * 32768 + 4096); LDSR(af0[3], aad0, (BUF) * 32768 + 6144); \
      LDSR(bf0[0], bad0, (BUF) * 32768 + 0); LDSR(bf0[1], bad0, (BUF) * 32768 + 2048); LDSR(bf0[2], bad0, (BUF) * 32768 + 4096); LDSR(bf0[3], bad0, (BUF) * 32768 + 6144); \
      LWAIT8(af0, bf0); \
      LDSR(af1[0], aad1, (BUF) * 32768 + 0); LDSR(af1[1], aad1, (BUF) * 32768 + 2048); LDSR(af1[2], aad1, (BUF) * 32768 + 4096); LDSR(af1[3], aad1, (BUF) * 32768 + 6144); \
      LDSR(bf1[0], bad1, (BUF) * 32768 + 0); LDSR(bf1[1], bad1, (BUF) * 32768 + 2048); LDSR(bf1[2], bad1, (BUF) * 32768 + 4096); LDSR(bf1[3], bad1, (BUF) * 32768 + 6144); \
      __builtin_amdgcn_s_setprio(1); \
      _Pragma("unroll") for (int i = 0; i < 4; ++i) _Pragma("unroll") for (int j = 0; j < 4; ++j) acc[i][j] = mfma16(bf0[j], af0[i], acc[i][j]); \
      LWAIT8(af1, bf1); \
      _Pragma("unroll") for (int i = 0; i < 4; ++i) _Pragma("unroll") for (int j = 0; j < 4; ++j) acc[i][j] = mfma16(bf1[j], af1[i], acc[i][j]); \
      __builtin_amdgcn_s_setprio(0); }
  G_DMA(0, 0);
  __syncthreads();
  for (int kt = 0; kt < nk; kt += 2) {
    G_DMA(kt + 1, 1);
    G_COMPUTE(0);
    __syncthreads();
    if (kt + 2 < nk) G_DMA(kt + 2, 0);
    G_COMPUTE(1);
    __syncthreads();
  }
#undef G_DMA
#undef G_DMA1
#undef G_COMPUTE
#undef LDSR
#undef LWAIT8
  if (dry) return;
#pragma unroll
  for (int mt = 0; mt < 4; ++mt) {
    const int row = m0 + wr * 64 + mt * 16 + (lane & 15);
#pragma unroll
    for (int nt = 0; nt < 4; ++nt) {
      const int col = n0 + wc * 64 + nt * 16 + (lane >> 4) * 4;
      f32x4 a = acc[mt][nt];
      if (EPI == EPI_IN) {
        if (col < DPJ) {
          uint2 pk; pk.x = pack2(a[0], a[1]); pk.y = pack2(a[2], a[3]);
          if (!((col >= C_KB && col < C_QI) || (col >= C_KI && col < C_WI))) *(uint2*)(p.proj + (size_t)row * DPJ + col) = pk;
          if (col >= C_KB && col < C_QI) {
            bool isv = col >= C_VB; int cc = col - (isv ? C_VB : C_KB);
            float* dst = (row < NPR) ? p.out + (isv ? OFF_VP : OFF_KP) + ((size_t)layer * NPR + row) * 64 + cc
                                     : p.out + (isv ? OFF_VS : OFF_KS) + ((size_t)layer * NSR + (row - NPR)) * 64 + cc;
            *(float4*)dst = make_float4(a[0], a[1], a[2], a[3]);
            *(uint2*)((isv ? p.vc : p.kc) + (size_t)row * 64 + cc) = pk;
          } else if (col >= C_KI && col < C_WI) {
            int cc = col - C_KI;
            *(uint2*)(p.kic + (size_t)row * 32 + cc) = pk;
            float* dst = (row < NPR) ? p.out + OFF_KIP + ((size_t)layer * NPR + row) * 32 + cc
                                     : p.out + OFF_KIS + ((size_t)layer * NSR + (row - NPR)) * 32 + cc;
            *(float4*)dst = make_float4(a[0], a[1], a[2], a[3]);
          }
        }
      } else if (EPI == EPI_OUT) {
        float4 xv;
        if (layer == 0) {
          const float* xin = row < NPR ? p.x_prompt + (size_t)row * DM : p.x_sample + (size_t)(row - NPR) * DM;
          xv = *(const float4*)(xin + col);
        } else {
          uint2 xr = *(const uint2*)(p.xb + (size_t)row * DM + col);
          xv = make_float4(bflo(xr.x), bfhi(xr.x), bflo(xr.y), bfhi(xr.y));
        }
        { uint2 zk; zk.x = pack2(ALPHA * xv.x + a[0], ALPHA * xv.y + a[1]); zk.y = pack2(ALPHA * xv.z + a[2], ALPHA * xv.w + a[3]);
          *(uint2*)(p.zb1 + (size_t)row * DM + col) = zk; }
      } else if (EPI == EPI_GU) {
        const int hrow = row - slab_row0;
        uint2 pk; pk.x = pack2(a[0], a[1]); pk.y = pack2(a[2], a[3]);
        if (col < DFF) {
          *(uint2*)(p.hg + (size_t)hrow * DFF + col) = pk;
          if (row < NPR) {
            int t = row & 8191;
            if (t >= 8190) *(float4*)(p.out + OFF_CP + ((size_t)(layer * 2 + (row >> 13)) * 2 + (t - 8190)) * DFF + col) = make_float4(a[0], a[1], a[2], a[3]);
          } else {
            int rs = row - NPR, t = rs & 15;
            if (t >= 14) *(float4*)(p.out + OFF_CS + ((size_t)(layer * 32 + (rs >> 4)) * 2 + (t - 14)) * DFF + col) = make_float4(a[0], a[1], a[2], a[3]);
          }
        } else {
          *(uint2*)(p.hu + (size_t)hrow * DFF + (col - DFF)) = pk;
        }
      } else {
        uint2 xr = *(const uint2*)(p.xb + (size_t)row * DM + col);
        uint2 zk; zk.x = pack2(ALPHA * bflo(xr.x) + a[0], ALPHA * bfhi(xr.x) + a[1]); zk.y = pack2(ALPHA * bflo(xr.y) + a[2], ALPHA * bfhi(xr.y) + a[3]);
        *(uint2*)(p.zb2 + (size_t)row * DM + col) = zk;
      }
    }
  }
}

__device__ __forceinline__ void ln_phase(const P& p, const float* __restrict__ g, const float* __restrict__ b, const bool dry, const bool wr_f32, const bool wr_bf16, const u16* __restrict__ zsrc) {
  const int tid_ = TID(); const int lane = tid_ & 63, wid = tid_ >> 6;
  const int gw = blockIdx.x * 4 + wid, nw = gridDim.x * 4;
  const int r0 = (int)(((long)gw * NR) / nw), r1 = (int)(((long)(gw + 1) * NR) / nw);
  for (int rb = r0; rb < r1; rb += 5) {
    float4 v[5][4];
#pragma unroll
    for (int rr = 0; rr < 5; ++rr) {
      const int rowl = (rb + rr < r1) ? rb + rr : r1 - 1;
      const u16* zr = zsrc + (size_t)rowl * DM;
#pragma unroll
      for (int i = 0; i < 4; ++i) { uint2 zz = *(const uint2*)(zr + i * 256 + lane * 4); v[rr][i] = make_float4(bflo(zz.x), bfhi(zz.x), bflo(zz.y), bfhi(zz.y)); }
    }
#pragma unroll
    for (int rr = 0; rr < 5; ++rr) {
      const int row = rb + rr;
      if (row >= r1) break;
      float* xr = p.out + (size_t)row * DM;
      float s = 0.f;
#pragma unroll
      for (int i = 0; i < 4; ++i) s += v[rr][i].x + v[rr][i].y + v[rr][i].z + v[rr][i].w;
#pragma unroll
      for (int o = 1; o < 64; o <<= 1) s += __shfl_xor(s, o);
      const float mean = s * (1.f / 1024.f);
      float q = 0.f;
#pragma unroll
      for (int i = 0; i < 4; ++i) { float a = v[rr][i].x - mean, bb = v[rr][i].y - mean, c = v[rr][i].z - mean, d = v[rr][i].w - mean; q += a * a + bb * bb + c * c + d * d; }
#pragma unroll
      for (int o = 1; o < 64; o <<= 1) q += __shfl_xor(q, o);
      const float rstd = rsqrtf(q * (1.f / 1024.f) + 1e-5f);
      if (!dry) {
#pragma unroll
        for (int i = 0; i < 4; ++i) {
          const int c = i * 256 + lane * 4;
          float4 gg = *(const float4*)(g + c), bb = *(const float4*)(b + c);
          float4 y;
          y.x = (v[rr][i].x - mean) * rstd * gg.x + bb.x; y.y = (v[rr][i].y - mean) * rstd * gg.y + bb.y;
          y.z = (v[rr][i].z - mean) * rstd * gg.z + bb.z; y.w = (v[rr][i].w - mean) * rstd * gg.w + bb.w;
          if (wr_f32) *(float4*)(xr + c) = y;
          if (wr_bf16) { uint2 pk; pk.x = pack2(y.x, y.y); pk.y = pack2(y.z, y.w); *(uint2*)(p.xb + (size_t)row * DM + c) = pk; }
        }
      }
    }
  }
}

__device__ __forceinline__ void unpack8(uint4 a, float* f) {
  f[0] = bflo(a.x); f[1] = bfhi(a.x); f[2] = bflo(a.y); f[3] = bfhi(a.y); f[4] = bflo(a.z); f[5] = bfhi(a.z); f[6] = bflo(a.w); f[7] = bfhi(a.w);
}
__device__ __forceinline__ void act_phase(const P& p, int layer, int slab, int slab_rows, const bool dry, const int bskip) {
  const int tid = TID();
  const int nitems = (slab_rows / 8) * (DFF / 8);
  const int ntask = (nitems + 255) / 256;
  const float* cw = p.conv_w + (size_t)layer * 3 * DFF;
  const float* cb = p.conv_b + (size_t)layer * DFF;
  if ((int)blockIdx.x < bskip) return;
  for (int t = blockIdx.x - bskip; t < ntask; t += gridDim.x - bskip) {
    const int item = t * 256 + tid;
    if (item < nitems) {
      const int rg = item / (DFF / 8), cc = item % (DFF / 8);
      const int c0 = cc * 8;
      const int hrow0 = rg * 8;
      const int row0 = (slab == 0) ? (hrow0 < 8192 ? hrow0 : NPR + (hrow0 - 8192)) : 8192 + hrow0;
      const int tt = (row0 < NPR) ? (row0 & 8191) : ((row0 - NPR) & 15);
      uint4 hgv[8], huv[8];
#pragma unroll
      for (int r = 0; r < 8; ++r) { hgv[r] = *(const uint4*)(p.hg + (size_t)(hrow0 + r) * DFF + c0); huv[r] = *(const uint4*)(p.hu + (size_t)(hrow0 + r) * DFF + c0); }
      float h1[8], h2[8];
      if (tt == 0) {
        if (row0 < NPR) {
#pragma unroll
          for (int e = 0; e < 8; ++e) { h1[e] = 0.f; h2[e] = 0.f; }
        } else {
          const float* st = p.state_conv + ((size_t)(layer * 32 + ((row0 - NPR) >> 4)) * 2) * DFF + c0;
#pragma unroll
          for (int e = 0; e < 8; ++e) { h2[e] = st[e]; h1[e] = st[DFF + e]; }
        }
      } else {
        unpack8(*(const uint4*)(p.hg + (size_t)(hrow0 - 1) * DFF + c0), h1);
        unpack8(*(const uint4*)(p.hg + (size_t)(hrow0 - 2) * DFF + c0), h2);
      }
      float w0[8], w1[8], w2[8], bb[8];
#pragma unroll
      for (int e = 0; e < 8; ++e) { w0[e] = cw[c0 + e]; w1[e] = cw[DFF + c0 + e]; w2[e] = cw[2 * DFF + c0 + e]; bb[e] = cb[c0 + e]; }
#pragma unroll
      for (int r = 0; r < 8; ++r) {
        float h0[8], uu[8], o[8];
        unpack8(hgv[r], h0); unpack8(huv[r], uu);
#pragma unroll
        for (int e = 0; e < 8; ++e) {
          float cv = bb[e] + w0[e] * h2[e] + w1[e] * h1[e] + w2[e] * h0[e];
          o[e] = gelu_f(cv) * uu[e];
          h2[e] = h1[e]; h1[e] = h0[e];
        }
        uint4 r4; r4.x = pack2(o[0], o[1]); r4.y = pack2(o[2], o[3]); r4.z = pack2(o[4], o[5]); r4.w = pack2(o[6], o[7]);
        if (!dry) *(uint4*)(p.hu + (size_t)(hrow0 + r) * DFF + c0) = r4;
      }
    }
  }
}

__device__ __forceinline__ void mixer_a_task(const P& p, int layer, int task, unsigned char* smem) {
  const int tid = TID(), lane = tid & 63, w = tid >> 6;
  int g, row0, CL, sb = 0; bool samp = false;
  if (task < 512) { g = task & 3; row0 = (task >> 2) * 128; CL = 128; }
  else { int ts = task - 512; g = ts & 3; sb = ts >> 2; row0 = NPR + sb * 16; CL = 16; samp = true; }
  u16* vnT = (u16*)smem;
  {
    const int r = tid >> 1, half = tid & 1;
    float v[32];
    if (r < CL) {
      const uint4* src = (const uint4*)(p.proj + (size_t)(row0 + r) * DPJ + C_VA + g * 64 + half * 32);
#pragma unroll
      for (int i = 0; i < 4; ++i) {
        uint4 a = src[i];
        v[i * 8 + 0] = gelu_f(bflo(a.x)); v[i * 8 + 1] = gelu_f(bfhi(a.x)); v[i * 8 + 2] = gelu_f(bflo(a.y)); v[i * 8 + 3] = gelu_f(bfhi(a.y));
        v[i * 8 + 4] = gelu_f(bflo(a.z)); v[i * 8 + 5] = gelu_f(bfhi(a.z)); v[i * 8 + 6] = gelu_f(bflo(a.w)); v[i * 8 + 7] = gelu_f(bfhi(a.w));
      }
    } else {
#pragma unroll
      for (int i = 0; i < 32; ++i) v[i] = 0.f;
    }
    float s = 0.f;
#pragma unroll
    for (int i = 0; i < 32; ++i) s += v[i];
    s += __shfl_xor(s, 1);
    const float mean = s * (1.f / 64.f);
    float q = 0.f;
#pragma unroll
    for (int i = 0; i < 32; ++i) { float d = v[i] - mean; q += d * d; }
    q += __shfl_xor(q, 1);
    const float rstd = rsqrtf(q * (1.f / 64.f) + 1e-5f);
    const float* lg = p.a_ln_g + layer * 256 + g * 64 + half * 32;
    const float* lb = p.a_ln_b + layer * 256 + g * 64 + half * 32;
#pragma unroll
    for (int i = 0; i < 32; ++i) {
      float y = (r < CL) ? (v[i] - mean) * rstd * lg[i] + lb[i] : 0.f;
      v[i] = y;
      vnT[(half * 32 + i) * 136 + r] = f2bf(y);
    }
    if (samp && r < CL) {
      float* dst = p.out + OFF_AV + ((size_t)(layer * 32 + sb) * 16 + r) * 256 + g * 64 + half * 32;
#pragma unroll
      for (int i = 0; i < 8; ++i) *(float4*)(dst + i * 4) = make_float4(v[i * 4], v[i * 4 + 1], v[i * 4 + 2], v[i * 4 + 3]);
    }
  }
  __syncthreads();
  {
    const int i0 = w * 32;
    f32x4 acc[2][4];
#pragma unroll
    for (int i = 0; i < 2; ++i)
#pragma unroll
      for (int j = 0; j < 4; ++j) acc[i][j] = (f32x4){0.f, 0.f, 0.f, 0.f};
    const float* Wg = p.a_ws + (size_t)(layer * 4 + g) * 128 * 128;
    if (i0 < CL) {
      for (int ks = 0; ks < 4; ++ks) {
        if (ks * 32 > i0 + 31 || ks * 32 >= CL) break;
        bf16x8 bfr[4];
#pragma unroll
        for (int nt = 0; nt < 4; ++nt) bfr[nt] = *(const bf16x8*)(vnT + (nt * 16 + (lane & 15)) * 136 + ks * 32 + (lane >> 4) * 8);
#pragma unroll
        for (int mt = 0; mt < 2; ++mt) {
          const int i = i0 + mt * 16 + (lane & 15);
          const int j0 = ks * 32 + (lane >> 4) * 8;
          const float* wp = Wg + (size_t)i * 128 + j0;
          float4 a = ((const float4*)wp)[0], b = ((const float4*)wp)[1];
          a.x = (j0 + 0 <= i) ? a.x : 0.f; a.y = (j0 + 1 <= i) ? a.y : 0.f; a.z = (j0 + 2 <= i) ? a.z : 0.f; a.w = (j0 + 3 <= i) ? a.w : 0.f;
          b.x = (j0 + 4 <= i) ? b.x : 0.f; b.y = (j0 + 5 <= i) ? b.y : 0.f; b.z = (j0 + 6 <= i) ? b.z : 0.f; b.w = (j0 + 7 <= i) ? b.w : 0.f;
          bf16x8 af = pack8(a, b);
#pragma unroll
          for (int nt = 0; nt < 4; ++nt) acc[mt][nt] = mfma16(bfr[nt], af, acc[mt][nt]);
        }
      }
#pragma unroll
      for (int mt = 0; mt < 2; ++mt) {
        const int i = i0 + mt * 16 + (lane & 15);
        if (i < CL) {
          const float bsv = p.a_bs[(layer * 4 + g) * 128 + i];
#pragma unroll
          for (int nt = 0; nt < 4; ++nt) {
            const int c = nt * 16 + (lane >> 4) * 4;
            uint2 u = *(const uint2*)(p.proj + (size_t)(row0 + i) * DPJ + C_UA + g * 64 + c);
            f32x4 a = acc[mt][nt];
            uint2 o;
            o.x = pack2(gelu_f(bflo(u.x)) * (a[0] + bsv), gelu_f(bfhi(u.x)) * (a[1] + bsv));
            o.y = pack2(gelu_f(bflo(u.y)) * (a[2] + bsv), gelu_f(bfhi(u.y)) * (a[3] + bsv));
            *(uint2*)(p.mix + (size_t)(row0 + i) * DM + g * 64 + c) = o;
          }
        }
      }
    }
  }
  __syncthreads();
}

__device__ __forceinline__ void ret_decode(int task, int& h, int& row0, int& CL, int& pos0, int& bidx, int& n, bool& samp) {
  if (task < 1536) { h = task % 6; int cn = task / 6; bidx = cn >> 7; n = cn & 127; row0 = cn * 64; CL = 64; pos0 = n * 64; samp = false; }
  else { int ts = task - 1536; h = ts % 6; bidx = ts / 6; n = 0; row0 = NPR + bidx * 16; CL = 16; pos0 = 2048; samp = true; }
}

__device__ __forceinline__ void rope_load(const P& p, const u16* src  , int q4, int pos, float scale, float* o1, float* o2) {
  uint4 a = *(const uint4*)(src + q4 * 8);
  uint4 b = *(const uint4*)(src + 32 + q4 * 8);
  float x1[8], x2[8];
  x1[0] = bflo(a.x); x1[1] = bfhi(a.x); x1[2] = bflo(a.y); x1[3] = bfhi(a.y); x1[4] = bflo(a.z); x1[5] = bfhi(a.z); x1[6] = bflo(a.w); x1[7] = bfhi(a.w);
  x2[0] = bflo(b.x); x2[1] = bfhi(b.x); x2[2] = bflo(b.y); x2[3] = bfhi(b.y); x2[4] = bflo(b.z); x2[5] = bfhi(b.z); x2[6] = bflo(b.w); x2[7] = bfhi(b.w);
  const float4* rp = (const float4*)(p.rope + ((size_t)pos * 32 + q4 * 8) * 2);
#pragma unroll
  for (int e = 0; e < 4; ++e) {
    float4 cs = rp[e];
    o1[2 * e] = (x1[2 * e] * cs.x - x2[2 * e] * cs.y) * scale;
    o2[2 * e] = (x1[2 * e] * cs.y + x2[2 * e] * cs.x) * scale;
    o1[2 * e + 1] = (x1[2 * e + 1] * cs.z - x2[2 * e + 1] * cs.w) * scale;
    o2[2 * e + 1] = (x1[2 * e + 1] * cs.w + x2[2 * e + 1] * cs.z) * scale;
  }
}

__device__ __forceinline__ void ret_kv_task(const P& p, int layer, int task, unsigned char* smem) {
  const int tid = TID(), lane = tid & 63, w = tid >> 6;
  int h, row0, CL, pos0, bidx, n; bool samp;
  ret_decode(task, h, row0, CL, pos0, bidx, n, samp);
  const float lg = head_lg(h);
  u16* kT = (u16*)smem;
  u16* vT = (u16*)(smem + 9216);
  {
    const int j = tid >> 2, q4 = tid & 3;
    if (j < CL) {
      float o1[8], o2[8];
      const float dec = 0.125f * __expf((float)(CL - 1 - j) * lg);
      rope_load(p, p.proj + (size_t)(row0 + j) * DPJ + C_KC + h * 64, q4, pos0 + j, dec, o1, o2);
#pragma unroll
      for (int e = 0; e < 8; ++e) { kT[(q4 * 8 + e) * 72 + j] = f2bf(o1[e]); kT[(32 + q4 * 8 + e) * 72 + j] = f2bf(o2[e]); }
      const uint4* vs = (const uint4*)(p.proj + (size_t)(row0 + j) * DPJ + C_VC + h * 64 + q4 * 16);
      uint4 a = vs[0], b = vs[1];
      u32 ww[8] = {a.x, a.y, a.z, a.w, b.x, b.y, b.z, b.w};
#pragma unroll
      for (int e = 0; e < 8; ++e) { vT[(q4 * 16 + 2 * e) * 72 + j] = (u16)(ww[e] & 0xffff); vT[(q4 * 16 + 2 * e + 1) * 72 + j] = (u16)(ww[e] >> 16); }
    } else {
#pragma unroll
      for (int e = 0; e < 8; ++e) { kT[(q4 * 8 + e) * 72 + j] = 0; kT[(32 + q4 * 8 + e) * 72 + j] = 0; }
#pragma unroll
      for (int e = 0; e < 16; ++e) vT[(q4 * 16 + e) * 72 + j] = 0;
    }
  }
  __syncthreads();
  {
    f32x4 acc[4];
#pragma unroll
    for (int nt = 0; nt < 4; ++nt) acc[nt] = (f32x4){0.f, 0.f, 0.f, 0.f};
#pragma unroll
    for (int ks = 0; ks < 2; ++ks) {
      bf16x8 af = *(const bf16x8*)(kT + (w * 16 + (lane & 15)) * 72 + ks * 32 + (lane >> 4) * 8);
#pragma unroll
      for (int nt = 0; nt < 4; ++nt) {
        bf16x8 bfr = *(const bf16x8*)(vT + (nt * 16 + (lane & 15)) * 72 + ks * 32 + (lane >> 4) * 8);
        acc[nt] = mfma16(bfr, af, acc[nt]);
      }
    }
    const int d = w * 16 + (lane & 15);
#pragma unroll
    for (int nt = 0; nt < 4; ++nt) {
      const int e = nt * 16 + (lane >> 4) * 4;
      if (!samp) {
        *(float4*)(p.kvbuf + (((size_t)(bidx * 6 + h) * 128 + n) * 64 + d) * 64 + e) = make_float4(acc[nt][0], acc[nt][1], acc[nt][2], acc[nt][3]);
      } else {
        const size_t o = ((size_t)(layer * 32 + bidx) * 6 + h) * 4096 + d * 64 + e;
        float4 r0 = *(const float4*)(p.state_ret + o);
        const float cd = __expf(16.f * lg);
        *(float4*)(p.out + OFF_RS + o) = make_float4(cd * r0.x + acc[nt][0], cd * r0.y + acc[nt][1], cd * r0.z + acc[nt][2], cd * r0.w + acc[nt][3]);
      }
    }
  }
  __syncthreads();
}

__device__ __forceinline__ void scan_phase(const P& p, int layer, const bool dry) {
  const int tid = TID();
  for (int t = blockIdx.x; t < 192; t += gridDim.x) {
    const int bh = t >> 4, part = t & 15;
    const int h = bh % 6;
    const float cd = __expf(64.f * head_lg(h));
    float* base = p.kvbuf + (size_t)bh * 128 * 4096 + part * 256 + tid;
    float r = 0.f;
    for (int n0 = 0; n0 < 128; n0 += 64) {
      float kv[64];
#pragma unroll
      for (int i = 0; i < 64; ++i) kv[i] = base[(size_t)(n0 + i) * 4096];
#pragma unroll
      for (int i = 0; i < 64; ++i) {
        if (!dry) base[(size_t)(n0 + i) * 4096] = r;
        r = cd * r + kv[i];
      }
    }
    if (!dry || r == 1.2345e30f) p.out[OFF_RP + ((size_t)layer * 12 + bh) * 4096 + part * 256 + tid] = r;
  }
}

__device__ __forceinline__ void ret_out_task(const P& p, int layer, int task, unsigned char* smem) {
  const int tid = TID(), lane = tid & 63, w = tid >> 6;
  int h, row0, CL, pos0, bidx, n; bool samp;
  ret_decode(task, h, row0, CL, pos0, bidx, n, samp);
  const float lg = head_lg(h);
  u16* sQ = (u16*)smem; u16* sK = sQ + 4608; u16* sVT = sK + 4608; u16* sRT = sVT + 4608; u16* sS = sRT + 4608;
  {
    const int j = tid >> 2, q4 = tid & 3;
    if (j < CL) {
      float o1[8], o2[8];
      rope_load(p, p.proj + (size_t)(row0 + j) * DPJ + C_QC + h * 64, q4, pos0 + j, 1.0f, o1, o2);
      *(bf16x8*)(sQ + j * 72 + q4 * 8) = pack8(make_float4(o1[0], o1[1], o1[2], o1[3]), make_float4(o1[4], o1[5], o1[6], o1[7]));
      *(bf16x8*)(sQ + j * 72 + 32 + q4 * 8) = pack8(make_float4(o2[0], o2[1], o2[2], o2[3]), make_float4(o2[4], o2[5], o2[6], o2[7]));
      rope_load(p, p.proj + (size_t)(row0 + j) * DPJ + C_KC + h * 64, q4, pos0 + j, 0.125f, o1, o2);
      *(bf16x8*)(sK + j * 72 + q4 * 8) = pack8(make_float4(o1[0], o1[1], o1[2], o1[3]), make_float4(o1[4], o1[5], o1[6], o1[7]));
      *(bf16x8*)(sK + j * 72 + 32 + q4 * 8) = pack8(make_float4(o2[0], o2[1], o2[2], o2[3]), make_float4(o2[4], o2[5], o2[6], o2[7]));
      const uint4* vs = (const uint4*)(p.proj + (size_t)(row0 + j) * DPJ + C_VC + h * 64 + q4 * 16);
      uint4 a = vs[0], b = vs[1];
      u32 ww[8] = {a.x, a.y, a.z, a.w, b.x, b.y, b.z, b.w};
#pragma unroll
      for (int e = 0; e < 8; ++e) { sVT[(q4 * 16 + 2 * e) * 72 + j] = (u16)(ww[e] & 0xffff); sVT[(q4 * 16 + 2 * e + 1) * 72 + j] = (u16)(ww[e] >> 16); }
    } else {
      uint4 z = make_uint4(0, 0, 0, 0);
      *(uint4*)(sQ + j * 72 + q4 * 8) = z; *(uint4*)(sQ + j * 72 + 32 + q4 * 8) = z;
      *(uint4*)(sK + j * 72 + q4 * 8) = z; *(uint4*)(sK + j * 72 + 32 + q4 * 8) = z;
#pragma unroll
      for (int e = 0; e < 16; ++e) sVT[(q4 * 16 + e) * 72 + j] = 0;
    }
    const int d = tid >> 2;
    const float* rsrc = samp ? p.state_ret + ((size_t)(layer * 32 + bidx) * 6 + h) * 4096 + d * 64 + q4 * 16
                             : p.kvbuf + (((size_t)(bidx * 6 + h) * 128 + n) * 64 + d) * 64 + q4 * 16;
#pragma unroll
    for (int i = 0; i < 4; ++i) {
      float4 r = ((const float4*)rsrc)[i];
      sRT[(q4 * 16 + i * 4 + 0) * 72 + d] = f2bf(r.x); sRT[(q4 * 16 + i * 4 + 1) * 72 + d] = f2bf(r.y);
      sRT[(q4 * 16 + i * 4 + 2) * 72 + d] = f2bf(r.z); sRT[(q4 * 16 + i * 4 + 3) * 72 + d] = f2bf(r.w);
    }
  }
  __syncthreads();
  const bool active = (w * 16 < CL);
  if (active) {
    bf16x8 qf0 = *(const bf16x8*)(sQ + (w * 16 + (lane & 15)) * 72 + (lane >> 4) * 8);
    bf16x8 qf1 = *(const bf16x8*)(sQ + (w * 16 + (lane & 15)) * 72 + 32 + (lane >> 4) * 8);
    const int ia = w * 16 + (lane & 15);
    for (int jt = 0; jt < 4; ++jt) {
      uint2 pk = make_uint2(0, 0);
      if (jt <= w) {
        f32x4 acc = (f32x4){0.f, 0.f, 0.f, 0.f};
        bf16x8 kf0 = *(const bf16x8*)(sK + (jt * 16 + (lane & 15)) * 72 + (lane >> 4) * 8);
        bf16x8 kf1 = *(const bf16x8*)(sK + (jt * 16 + (lane & 15)) * 72 + 32 + (lane >> 4) * 8);
        acc = mfma16(kf0, qf0, acc); acc = mfma16(kf1, qf1, acc);
        const int ja = jt * 16 + (lane >> 4) * 4;
        float s[4];
#pragma unroll
        for (int jj = 0; jj < 4; ++jj) { int df = ia - (ja + jj); s[jj] = (df >= 0) ? acc[jj] * __expf((float)df * lg) : 0.f; }
        pk.x = pack2(s[0], s[1]); pk.y = pack2(s[2], s[3]);
      }
      *(uint2*)(sS + ia * 72 + jt * 16 + (lane >> 4) * 4) = pk;
    }
  }
  __syncthreads();
  if (active) {
    f32x4 ai[4], ac[4];
#pragma unroll
    for (int nt = 0; nt < 4; ++nt) { ai[nt] = (f32x4){0.f, 0.f, 0.f, 0.f}; ac[nt] = (f32x4){0.f, 0.f, 0.f, 0.f}; }
#pragma unroll
    for (int ks = 0; ks < 2; ++ks) {
      bf16x8 sf = *(const bf16x8*)(sS + (w * 16 + (lane & 15)) * 72 + ks * 32 + (lane >> 4) * 8);
      bf16x8 qf = *(const bf16x8*)(sQ + (w * 16 + (lane & 15)) * 72 + ks * 32 + (lane >> 4) * 8);
#pragma unroll
      for (int nt = 0; nt < 4; ++nt) {
        bf16x8 vf = *(const bf16x8*)(sVT + (nt * 16 + (lane & 15)) * 72 + ks * 32 + (lane >> 4) * 8);
        bf16x8 rf = *(const bf16x8*)(sRT + (nt * 16 + (lane & 15)) * 72 + ks * 32 + (lane >> 4) * 8);
        ai[nt] = mfma16(vf, sf, ai[nt]); ac[nt] = mfma16(rf, qf, ac[nt]);
      }
    }
    const int il = w * 16 + (lane & 15);
    const float qd = __expf((float)(il + 1) * lg);
    float y[16]; float s = 0.f;
#pragma unroll
    for (int nt = 0; nt < 4; ++nt)
#pragma unroll
      for (int jj = 0; jj < 4; ++jj) { y[nt * 4 + jj] = ai[nt][jj] + qd * ac[nt][jj]; s += y[nt * 4 + jj]; }
    s += __shfl_xor(s, 16); s += __shfl_xor(s, 32);
    const float mean = s * (1.f / 64.f);
    float q = 0.f;
#pragma unroll
    for (int i = 0; i < 16; ++i) { float dd = y[i] - mean; q += dd * dd; }
    q += __shfl_xor(q, 16); q += __shfl_xor(q, 32);
    const float rstd = rsqrtf(q * (1.f / 64.f) + 1e-5f);
    if (il < CL) {
#pragma unroll
      for (int nt = 0; nt < 4; ++nt) {
        const int e = nt * 16 + (lane >> 4) * 4;
        float4 gg = *(const float4*)(p.c_gn_g + layer * 384 + h * 64 + e);
        uint2 gr = *(const uint2*)(p.proj + (size_t)(row0 + il) * DPJ + C_GC + h * 64 + e);
        uint2 o;
        o.x = pack2(silu_f(bflo(gr.x)) * (y[nt * 4 + 0] - mean) * rstd * gg.x, silu_f(bfhi(gr.x)) * (y[nt * 4 + 1] - mean) * rstd * gg.y);
        o.y = pack2(silu_f(bflo(gr.y)) * (y[nt * 4 + 2] - mean) * rstd * gg.z, silu_f(bfhi(gr.y)) * (y[nt * 4 + 3] - mean) * rstd * gg.w);
        *(uint2*)(p.mix + (size_t)(row0 + il) * DM + 640 + h * 64 + e) = o;
      }
    }
  }
  __syncthreads();
}

constexpr int DS_SEL = 32768, DS_CS = 36864, DS_CI = 40960, DS_STAT = 43008, DS_THR = 43072, DS_CNT = 43136, DS_NV = 43200;
constexpr int CANDC = 128;

template <bool SAMPLE> __forceinline__
__device__ __forceinline__ void dsa_task(const P& p, int layer, int qrow0, int kb_row0, int sb, int L, unsigned char* smem) {
  const int tid = TID(), lane = tid & 63, w = tid >> 6;
  u32* hist = (u32*)smem;
  u16* sel = (u16*)(smem + DS_SEL);
  float* cand_s = (float*)(smem + DS_CS);
  u16* cand_i = (u16*)(smem + DS_CI);
  float* stats = (float*)(smem + DS_STAT);
  int* thr = (int*)(smem + DS_THR);
  u32* cnt = (u32*)(smem + DS_CNT);
  int* nval = (int*)(smem + DS_NV);

  auto ki_frag = [&](int key, int koff) -> bf16x8 {
    if (SAMPLE) {
      if (key < 2048) {
        const float* f = p.cache_ki + (((size_t)layer * 32 + sb) * 2048 + key) * 32 + koff;
        return pack8(((const float4*)f)[0], ((const float4*)f)[1]);
      }
      return *(const bf16x8*)(p.kic + (size_t)(kb_row0 + key - 2048) * 32 + koff);
    }
    return *(const bf16x8*)(p.kic + (size_t)(kb_row0 + key) * 32 + koff);
  };

  if (L <= 256) {
    for (int i = tid; i < 8 * 256; i += 256) sel[i] = (u16)(i & 255);
    if (tid < 8) nval[tid] = L;
    __syncthreads();
  } else {
    bf16x8 qa[2][2], a2[2][2];
    {
      const int r = lane & 31; const int hh = (r >> 2) & 1; const int i = (r >> 3) * 4 + (r & 3);
      const int qit = 2 * hh + (i >> 3), head = i & 7;
#pragma unroll
      for (int T = 0; T < 2; ++T)
#pragma unroll
        for (int ks = 0; ks < 2; ++ks)
          qa[T][ks] = *(const bf16x8*)(p.proj + (size_t)(qrow0 + 4 * T + qit) * DPJ + C_QI + head * 32 + ks * 16 + (lane >> 5) * 8);
      const int kh = lane >> 5;
#pragma unroll
      for (int T = 0; T < 2; ++T)
#pragma unroll
        for (int ks = 0; ks < 2; ++ks) {
          bf16x8 v = (bf16x8){0, 0, 0, 0, 0, 0, 0, 0};
          if (r == (2 * T + ks) * 8 + 4 * kh) v = *(const bf16x8*)(p.proj + (size_t)(qrow0 + 4 * T + 2 * kh + ks) * DPJ + C_WI);
          a2[T][ks] = v;
        }
    }
#define LOADK(T_, K0, K1) { int key_ = (T_) * 32 + (lane & 31); int kc_ = key_ < L ? key_ : L - 1; K0 = ki_frag(kc_, (lane >> 5) * 8); K1 = ki_frag(kc_, 16 + (lane >> 5) * 8); }
    auto score_k = [&](bf16x8 kf0, bf16x8 kf1, float* sc) {
      __builtin_amdgcn_s_setprio(1);
      f32x16 accS;
#pragma unroll
      for (int i = 0; i < 16; ++i) accS[i] = 0.f;
#pragma unroll
      for (int T = 0; T < 2; ++T) {
        f32x16 acc;
#pragma unroll
        for (int i = 0; i < 16; ++i) acc[i] = 0.f;
        acc = mfma32(qa[T][0], kf0, acc); acc = mfma32(qa[T][1], kf1, acc);
#pragma unroll
        for (int ks = 0; ks < 2; ++ks) {
          uint4 b4;
          b4.x = pack2_relu(acc[8 * ks + 0], acc[8 * ks + 1]); b4.y = pack2_relu(acc[8 * ks + 2], acc[8 * ks + 3]);
          b4.z = pack2_relu(acc[8 * ks + 4], acc[8 * ks + 5]); b4.w = pack2_relu(acc[8 * ks + 6], acc[8 * ks + 7]);
          accS = mfma32(a2[T][ks], __builtin_bit_cast(bf16x8, b4), accS);
        }
      }
      sc[0] = accS[0]; sc[1] = accS[4]; sc[2] = accS[8]; sc[3] = accS[12];
      __builtin_amdgcn_s_setprio(0);
    };
    const int qbase = 2 * (lane >> 5);
    for (int i = tid; i < 8192 / 4; i += 256) ((uint4*)hist)[i] = make_uint4(0, 0, 0, 0);
    if (tid < 16) stats[tid] = 0.f;
    if (tid < 16) cnt[tid] = 0;
    __syncthreads();
    {
      float sm[4] = {0.f, 0.f, 0.f, 0.f}, sq[4] = {0.f, 0.f, 0.f, 0.f};
      bf16x8 a0, a1, b0, b1;
      LOADK(w, a0, a1); LOADK(w + 4, b0, b1);
      { float sc[4]; score_k(a0, a1, sc);
#pragma unroll
        for (int x = 0; x < 4; ++x) { sm[x] += sc[x]; sq[x] += sc[x] * sc[x]; } }
      { float sc[4]; score_k(b0, b1, sc);
#pragma unroll
        for (int x = 0; x < 4; ++x) { sm[x] += sc[x]; sq[x] += sc[x] * sc[x]; } }
#pragma unroll
      for (int x = 0; x < 4; ++x) {
#pragma unroll
        for (int o = 1; o < 32; o <<= 1) { sm[x] += __shfl_xor(sm[x], o); sq[x] += __shfl_xor(sq[x], o); }
      }
      if ((lane & 31) == 0) {
#pragma unroll
        for (int x = 0; x < 4; ++x) { int q = 4 * (x >> 1) + qbase + (x & 1); atomicAdd(&stats[q * 2], sm[x]); atomicAdd(&stats[q * 2 + 1], sq[x]); }
      }
    }
    __syncthreads();
    float mu[4], inv[4];
#pragma unroll
    for (int x = 0; x < 4; ++x) {
      int q = 4 * (x >> 1) + qbase + (x & 1);
      float m = stats[q * 2] * (1.f / 256.f);
      float var = stats[q * 2 + 1] * (1.f / 256.f) - m * m;
      mu[x] = m; inv[x] = 128.f * rsqrtf(fmaxf(var, 1e-20f));
    }
    const int ntiles = (L + 31) >> 5;
#define CLAMPT(T_) ((T_) < ntiles ? (T_) : ntiles - 1)
    {
      auto body1 = [&](bf16x8 k0, bf16x8 k1, int t) {
        float sc[4]; score_k(k0, k1, sc);
        if (t * 32 + (lane & 31) < L) {
#pragma unroll
          for (int x = 0; x < 4; ++x) {
            int q = 4 * (x >> 1) + qbase + (x & 1);
            int bin = (int)((sc[x] - mu[x]) * inv[x]) + 512; bin = bin < 0 ? 0 : (bin > 1023 ? 1023 : bin);
            atomicAdd(&hist[q * 1024 + bin], 1u);
          }
        }
      };
      bf16x8 a0, a1, b0, b1, c0, c1, d0, d1;
      LOADK(CLAMPT(w), a0, a1); LOADK(CLAMPT(w + 4), b0, b1); LOADK(CLAMPT(w + 8), c0, c1);
      for (int t = w; t < ntiles; t += 16) {
        LOADK(CLAMPT(t + 12), d0, d1); body1(a0, a1, t);
        if (t + 4 < ntiles) { LOADK(CLAMPT(t + 16), a0, a1); body1(b0, b1, t + 4); }
        if (t + 8 < ntiles) { LOADK(CLAMPT(t + 20), b0, b1); body1(c0, c1, t + 8); }
        if (t + 12 < ntiles) { LOADK(CLAMPT(t + 24), c0, c1); body1(d0, d1, t + 12); }
      }
    }
    __syncthreads();
    for (int qq = 0; qq < 2; ++qq) {
      const int q = 2 * w + qq;
      const uint4* hp = (const uint4*)(hist + q * 1024 + lane * 16);
      uint4 h0 = hp[0], h1 = hp[1], h2 = hp[2], h3 = hp[3];
      u32 hv[16] = {h0.x, h0.y, h0.z, h0.w, h1.x, h1.y, h1.z, h1.w, h2.x, h2.y, h2.z, h2.w, h3.x, h3.y, h3.z, h3.w};
      u32 tot = 0;
#pragma unroll
      for (int i = 0; i < 16; ++i) tot += hv[i];
      u32 incl = tot;
#pragma unroll
      for (int o = 1; o < 64; o <<= 1) { u32 v = __shfl_down(incl, o); if (lane + o < 64) incl += v; }
      unsigned long long bal = __ballot(incl >= 256u);
      const int Ls = 63 - __clzll(bal);
      if (lane == Ls) {
        u32 cum = incl - tot; int bstar = lane * 16; u32 nab = cum; bool found = false;
#pragma unroll
        for (int b = 15; b >= 0; --b) {
          if (!found) { if (cum + hv[b] >= 256u) { bstar = lane * 16 + b; nab = cum; found = true; } else cum += hv[b]; }
        }
        thr[q * 2] = bstar; thr[q * 2 + 1] = (int)nab;
      }
    }
    __syncthreads();
    int bst[4];
#pragma unroll
    for (int x = 0; x < 4; ++x) { int q = 4 * (x >> 1) + qbase + (x & 1); bst[x] = thr[q * 2]; }
    {
      auto body2 = [&](bf16x8 k0, bf16x8 k1, int t) {
        float sc[4]; score_k(k0, k1, sc);
        const int key = t * 32 + (lane & 31);
        if (key < L) {
#pragma unroll
          for (int x = 0; x < 4; ++x) {
            int q = 4 * (x >> 1) + qbase + (x & 1);
            int bin = (int)((sc[x] - mu[x]) * inv[x]) + 512; bin = bin < 0 ? 0 : (bin > 1023 ? 1023 : bin);
            if (bin > bst[x]) { u32 s_ = atomicAdd(&cnt[q * 2], 1u); if (s_ < 256u) sel[q * 256 + s_] = (u16)key; }
            else if (bin == bst[x]) { u32 s_ = atomicAdd(&cnt[q * 2 + 1], 1u); if (s_ < (u32)CANDC) { cand_s[q * CANDC + s_] = sc[x]; cand_i[q * CANDC + s_] = (u16)key; } }
          }
        }
      };
      bf16x8 a0, a1, b0, b1, c0, c1, d0, d1;
      LOADK(CLAMPT(w), a0, a1); LOADK(CLAMPT(w + 4), b0, b1); LOADK(CLAMPT(w + 8), c0, c1);
      for (int t = w; t < ntiles; t += 16) {
        LOADK(CLAMPT(t + 12), d0, d1); body2(a0, a1, t);
        if (t + 4 < ntiles) { LOADK(CLAMPT(t + 16), a0, a1); body2(b0, b1, t + 4); }
        if (t + 8 < ntiles) { LOADK(CLAMPT(t + 20), b0, b1); body2(c0, c1, t + 8); }
        if (t + 12 < ntiles) { LOADK(CLAMPT(t + 24), c0, c1); body2(d0, d1, t + 12); }
      }
    }
#undef CLAMPT
#undef LOADK
    __syncthreads();
    for (int qq = 0; qq < 2; ++qq) {
      const int q = 2 * w + qq;
      int m = (int)cnt[q * 2 + 1]; m = m > CANDC ? CANDC : m;
      const int nab = thr[q * 2 + 1];
      const int r = 256 - nab;
      for (int a = lane; a < m; a += 64) {
        const float sa = cand_s[q * CANDC + a]; const int ia = cand_i[q * CANDC + a];
        int rank = 0;
        for (int b = 0; b < m; ++b) {
          const float sbv = cand_s[q * CANDC + b]; const int ib = cand_i[q * CANDC + b];
          rank += ((sbv > sa) || (sbv == sa && ib < ia)) ? 1 : 0;
        }
        if (rank < r) sel[q * 256 + nab + rank] = (u16)ia;
      }
      if (lane == 0) nval[q] = nab + (r < m ? r : m);
    }
    __syncthreads();
  }

  float* Pbuf = (float*)smem + w * 2048;
  for (int qq = 0; qq < 2; ++qq) {
    const int q = 2 * w + qq;
    const int qrow = qrow0 + q;
    const int nv = nval[q];
    if (!SAMPLE) {
      typedef __attribute__((address_space(3))) unsigned lds_u32;
      typedef unsigned u32x2 __attribute__((ext_vector_type(2)));
      const int head = lane & 15;
      bf16x8 qf0, qf1;
      if (head < 6) {
        qf0 = *(const bf16x8*)(p.proj + (size_t)qrow * DPJ + C_QB + head * 64 + (lane >> 4) * 8);
        qf1 = *(const bf16x8*)(p.proj + (size_t)qrow * DPJ + C_QB + head * 64 + 32 + (lane >> 4) * 8);
      } else {
        qf0 = (bf16x8){0, 0, 0, 0, 0, 0, 0, 0}; qf1 = qf0;
      }
      f32x4 lgt[16];
#pragma unroll
      for (int kt = 0; kt < 16; ++kt) {
        const int slot = kt * 16 + (lane & 15);
        const int idx = slot < nv ? (int)sel[q * 256 + slot] : 0;
        const u16* kp = p.kc + (size_t)(kb_row0 + idx) * 64 + (lane >> 4) * 8;
        bf16x8 kf0 = *(const bf16x8*)kp, kf1 = *(const bf16x8*)(kp + 32);
        f32x4 acc = (f32x4){0.f, 0.f, 0.f, 0.f};
        acc = mfma16(kf0, qf0, acc); acc = mfma16(kf1, qf1, acc);
#pragma unroll
        for (int jj = 0; jj < 4; ++jj) lgt[kt][jj] = (kt * 16 + (lane >> 4) * 4 + jj) < nv ? acc[jj] * 0.125f : -INFINITY;
        if ((kt & 7) == 7) __builtin_amdgcn_sched_barrier(0);
      }
      float mx = -INFINITY;
#pragma unroll
      for (int kt = 0; kt < 16; ++kt)
#pragma unroll
        for (int jj = 0; jj < 4; ++jj) mx = fmaxf(mx, lgt[kt][jj]);
      mx = fmaxf(mx, __shfl_xor(mx, 16)); mx = fmaxf(mx, __shfl_xor(mx, 32));
      float sm = 0.f;
#pragma unroll
      for (int kt = 0; kt < 16; ++kt)
#pragma unroll
        for (int jj = 0; jj < 4; ++jj) { float e = __expf(lgt[kt][jj] - mx); lgt[kt][jj] = e; sm += e; }
      sm += __shfl_xor(sm, 16); sm += __shfl_xor(sm, 32);
      const float inv = 1.f / sm;
      unsigned char* Pw = smem + w * 3200;
      unsigned char* Vb0 = smem + 12800 + w * 4096;
      unsigned char* Vb1 = smem + 43264 + w * 4096;
      asm volatile("s_waitcnt vmcnt(0) lgkmcnt(0)" ::: "memory");
      if (head < 6) {
#pragma unroll
        for (int kt = 0; kt < 16; ++kt) {
          uint2 pk; pk.x = pack2(lgt[kt][0] * inv, lgt[kt][1] * inv); pk.y = pack2(lgt[kt][2] * inv, lgt[kt][3] * inv);
          *(uint2*)(Pw + head * 528 + (kt * 16 + (lane >> 4) * 4) * 2) = pk;
        }
      }
      const int drow = lane >> 3;
      const int dch0 = (((lane & 7) ^ (((lane >> 4) & 1) * 2)) << 3);
      const int dch1 = (((lane & 7) ^ (((lane >> 4) & 1) * 2 + 4)) << 3);
      bf16x8 af[8];
      int vidx[8][4];
#pragma unroll
      for (int ks = 0; ks < 8; ++ks) {
        af[ks] = (bf16x8){0, 0, 0, 0, 0, 0, 0, 0};
        if (head < 6) af[ks] = *(const bf16x8*)(Pw + head * 528 + (ks * 32 + (lane >> 4) * 8) * 2);
#pragma unroll
        for (int i = 0; i < 4; ++i) { const int slot_ = ks * 32 + i * 8 + drow; vidx[ks][i] = slot_ < nv ? (int)sel[q * 256 + slot_] : 0; }
      }
      asm volatile("s_waitcnt lgkmcnt(0)" ::: "memory");
#define PV_DMA(KS, BUF) { _Pragma("unroll") for (int i = 0; i < 4; ++i) { \
          __builtin_amdgcn_global_load_lds((const unsigned*)(p.vc + (size_t)(kb_row0 + vidx[KS][i]) * 64 + ((i & 1) ? dch1 : dch0)), (lds_u32*)((BUF) + i * 1024 + lane * 16), 16, 0, 0); } }
      const int tg = lane >> 4, tq = (lane & 15) >> 2, tp = lane & 3;
      const int trow = 8 * tg + tq, tf = ((tq >> 1) & 1) * 2 + (tg & 1) * 4;
      unsigned tad[4];
#pragma unroll
      for (int nt = 0; nt < 4; ++nt) tad[nt] = (unsigned)(trow * 128 + (((2 * nt + (tp >> 1)) ^ tf) << 4) + 8 * (tp & 1));
      const unsigned vb0a = (unsigned)(size_t)((__attribute__((address_space(3))) unsigned char*)Vb0);
      const unsigned vb1a = (unsigned)(size_t)((__attribute__((address_space(3))) unsigned char*)Vb1);
      f32x4 o[4];
#pragma unroll
      for (int nt = 0; nt < 4; ++nt) o[nt] = (f32x4){0.f, 0.f, 0.f, 0.f};
#define PV_STEP(KS, VBA) { u32x2 lo[4], hi[4]; \
        _Pragma("unroll") for (int nt = 0; nt < 4; ++nt) { \
          asm volatile("ds_read_b64_tr_b16 %0, %1" : "=v"(lo[nt]) : "v"((VBA) + tad[nt])); \
          asm volatile("ds_read_b64_tr_b16 %0, %1 offset:512" : "=v"(hi[nt]) : "v"((VBA) + tad[nt])); } \
        asm volatile("s_waitcnt lgkmcnt(0)" : "+v"(lo[0]), "+v"(lo[1]), "+v"(lo[2]), "+v"(lo[3]), "+v"(hi[0]), "+v"(hi[1]), "+v"(hi[2]), "+v"(hi[3]) :: "memory"); \
        _Pragma("unroll") for (int nt = 0; nt < 4; ++nt) { uint4 b4; b4.x = lo[nt].x; b4.y = lo[nt].y; b4.z = hi[nt].x; b4.w = hi[nt].y; \
          o[nt] = mfma16(af[KS], __builtin_bit_cast(bf16x8, b4), o[nt]); } }
      const int nks = (nv + 31) >> 5;
      PV_DMA(0, Vb0);
#pragma unroll
      for (int ks = 0; ks < 8; ks += 2) {
        if (ks < nks) {
          PV_DMA(ks + 1, Vb1);
          asm volatile("s_waitcnt vmcnt(4)" ::: "memory");
          PV_STEP(ks, vb0a);
          if (ks + 2 < nks) {
            if (ks + 2 < 8) PV_DMA((ks + 2 < 8 ? ks + 2 : 0), Vb0);
            asm volatile("s_waitcnt vmcnt(4)" ::: "memory");
          } else asm volatile("s_waitcnt vmcnt(0)" ::: "memory");
          PV_STEP(ks + 1, vb1a);
        }
      }
#undef PV_DMA
#undef PV_STEP
      if (lane < 32) {
#pragma unroll
        for (int nt = 0; nt < 4; ++nt)
#pragma unroll
          for (int jj = 0; jj < 4; ++jj) {
            const int hd = (lane >> 4) * 4 + jj;
            if (hd < 6) p.mix[(size_t)qrow * DM + 256 + hd * 64 + nt * 16 + (lane & 15)] = f2bf(o[nt][jj]);
          }
      }
    } else {
    const int head = lane & 15;
    bf16x8 qf0, qf1;
    if (head < 6) {
      qf0 = *(const bf16x8*)(p.proj + (size_t)qrow * DPJ + C_QB + head * 64 + (lane >> 4) * 8);
      qf1 = *(const bf16x8*)(p.proj + (size_t)qrow * DPJ + C_QB + head * 64 + 32 + (lane >> 4) * 8);
    } else {
      qf0 = (bf16x8){0, 0, 0, 0, 0, 0, 0, 0}; qf1 = qf0;
    }
    f32x4 lgt[16];
#pragma unroll
    for (int kt = 0; kt < 16; ++kt) {
      const int slot = kt * 16 + (lane & 15);
      const int idx = slot < nv ? (int)sel[q * 256 + slot] : 0;
      bf16x8 kf0, kf1;
      if (SAMPLE) {
        if (idx < 2048) {
          const float* f = p.cache_k + (((size_t)layer * 32 + sb) * 2048 + idx) * 64 + (lane >> 4) * 8;
          kf0 = pack8(((const float4*)f)[0], ((const float4*)f)[1]);
          kf1 = pack8(((const float4*)(f + 32))[0], ((const float4*)(f + 32))[1]);
        } else {
          const u16* kp = p.kc + (size_t)(kb_row0 + idx - 2048) * 64 + (lane >> 4) * 8;
          kf0 = *(const bf16x8*)kp; kf1 = *(const bf16x8*)(kp + 32);
        }
      } else {
        const u16* kp = p.kc + (size_t)(kb_row0 + idx) * 64 + (lane >> 4) * 8;
        kf0 = *(const bf16x8*)kp; kf1 = *(const bf16x8*)(kp + 32);
      }
      f32x4 acc = (f32x4){0.f, 0.f, 0.f, 0.f};
      acc = mfma16(qf0, kf0, acc); acc = mfma16(qf1, kf1, acc);
      const bool ok = slot < nv;
#pragma unroll
      for (int jj = 0; jj < 4; ++jj) lgt[kt][jj] = ok ? acc[jj] * 0.125f : -INFINITY;
      if ((kt & 7) == 7) __builtin_amdgcn_sched_barrier(0);
    }
    float inv_[4], mx_[4];
#pragma unroll
    for (int jj = 0; jj < 4; ++jj) {
      float mx = -INFINITY;
#pragma unroll
      for (int kt = 0; kt < 16; ++kt) mx = fmaxf(mx, lgt[kt][jj]);
#pragma unroll
      for (int o = 1; o < 16; o <<= 1) mx = fmaxf(mx, __shfl_xor(mx, o));
      float sm = 0.f;
#pragma unroll
      for (int kt = 0; kt < 16; ++kt) { float e = __expf(lgt[kt][jj] - mx); lgt[kt][jj] = e; sm += e; }
#pragma unroll
      for (int o = 1; o < 16; o <<= 1) sm += __shfl_xor(sm, o);
      inv_[jj] = 1.f / sm; mx_[jj] = mx;
    }
    asm volatile("s_waitcnt lgkmcnt(0)" ::: "memory");
    __builtin_amdgcn_wave_barrier();
    if (lane < 32) {
      const int hb = (lane >> 4) * 4;
#pragma unroll
      for (int kt = 0; kt < 16; ++kt) {
        const int slot = kt * 16 + (lane & 15);
        if (hb == 0) {
          *(float4*)(Pbuf + slot * 8) = make_float4(lgt[kt][0] * inv_[0], lgt[kt][1] * inv_[1], lgt[kt][2] * inv_[2], lgt[kt][3] * inv_[3]);
        } else {
          *(float2*)(Pbuf + slot * 8 + 4) = make_float2(lgt[kt][0] * inv_[0], lgt[kt][1] * inv_[1]);
        }
      }
    }
    asm volatile("s_waitcnt lgkmcnt(0)" ::: "memory");
    __builtin_amdgcn_wave_barrier();
    {
      typedef float f2v __attribute__((ext_vector_type(2)));
      const int sg = lane >> 3, dc = lane & 7;
      f2v o[6][4];
#pragma unroll
      for (int hh = 0; hh < 6; ++hh)
#pragma unroll
        for (int j = 0; j < 4; ++j) o[hh][j] = (f2v){0.f, 0.f};
      const int nit = (nv + 7) >> 3;
#pragma unroll 8
      for (int it = 0; it < nit; ++it) {
        const int slot = it * 8 + sg;
        const int idx = slot < nv ? (int)sel[q * 256 + slot] : 0;
        f2v vv[4];
        if (SAMPLE) {
          if (idx < 2048) {
            const float* vp = p.cache_v + (((size_t)layer * 32 + sb) * 2048 + idx) * 64 + dc * 8;
            float4 x0 = ((const float4*)vp)[0], x1 = ((const float4*)vp)[1];
            vv[0] = (f2v){x0.x, x0.y}; vv[1] = (f2v){x0.z, x0.w}; vv[2] = (f2v){x1.x, x1.y}; vv[3] = (f2v){x1.z, x1.w};
          } else {
            uint4 x = *(const uint4*)(p.vc + (size_t)(kb_row0 + idx - 2048) * 64 + dc * 8);
            vv[0] = (f2v){bflo(x.x), bfhi(x.x)}; vv[1] = (f2v){bflo(x.y), bfhi(x.y)}; vv[2] = (f2v){bflo(x.z), bfhi(x.z)}; vv[3] = (f2v){bflo(x.w), bfhi(x.w)};
          }
        } else {
          uint4 x = *(const uint4*)(p.vc + (size_t)(kb_row0 + idx) * 64 + dc * 8);
          vv[0] = (f2v){bflo(x.x), bfhi(x.x)}; vv[1] = (f2v){bflo(x.y), bfhi(x.y)}; vv[2] = (f2v){bflo(x.z), bfhi(x.z)}; vv[3] = (f2v){bflo(x.w), bfhi(x.w)};
        }
        float4 pa = *(const float4*)(Pbuf + slot * 8);
        float2 pb = *(const float2*)(Pbuf + slot * 8 + 4);
        const float ph_[6] = {pa.x, pa.y, pa.z, pa.w, pb.x, pb.y};
#pragma unroll
        for (int hh = 0; hh < 6; ++hh) {
          const f2v pp = (f2v){ph_[hh], ph_[hh]};
#pragma unroll
          for (int j = 0; j < 4; ++j) o[hh][j] = pp * vv[j] + o[hh][j];
        }
      }
#pragma unroll
      for (int hh = 0; hh < 6; ++hh) {
#pragma unroll
        for (int j = 0; j < 4; ++j) {
#pragma unroll
          for (int m = 8; m < 64; m <<= 1) { o[hh][j].x += __shfl_xor(o[hh][j].x, m); o[hh][j].y += __shfl_xor(o[hh][j].y, m); }
        }
        if (lane < 8) {
          uint4 r4; r4.x = pack2(o[hh][0].x, o[hh][0].y); r4.y = pack2(o[hh][1].x, o[hh][1].y); r4.z = pack2(o[hh][2].x, o[hh][2].y); r4.w = pack2(o[hh][3].x, o[hh][3].y);
          *(uint4*)(p.mix + (size_t)qrow * DM + 256 + hh * 64 + dc * 8) = r4;
        }
      }
    }
    }
  }
  __syncthreads();
}

constexpr int NT_KV = 1536 + 192, NT_MA = 512 + 128, NT_DS = 64, NT_DP = 2048;

#define WQ_BASE 3520
#define WQ_WORDS 3712
__device__ __forceinline__ int wq_next(unsigned* ctr, int* s_task) {
  __syncthreads();
  if (threadIdx.x == 0) *s_task = (int)atomicAdd(ctr, 1u);
  __syncthreads();
  return *s_task;
}
#define WQ_LOOP(CTR, N, VAR, ...) { int VAR = wq_next(CTR, s_task); while (VAR < (N)) { \
    if (threadIdx.x == 0) s_task[1] = (int)atomicAdd(CTR, 1u); \
    __VA_ARGS__; \
    VAR = s_task[1]; __syncthreads(); } }
__device__ __forceinline__ void mix1_phase(const P& p, int layer, unsigned char* smem, const int sub, int* s_task) {
  unsigned* ctr = p.bar + WQ_BASE + layer * 64;
  if (sub & 4) WQ_LOOP(ctr, NT_DS, s, { int sb = s >> 1, sb2 = s & 1;
    dsa_task<true>(p, layer, NPR + sb * 16 + sb2 * 8, NPR + sb * 16, sb, 2064, smem); })
  if (sub & 8) WQ_LOOP(ctr + 16, NT_DP, d, { int c = 127 - (d >> 4); int bb = (d >> 3) & 1; int sb2 = d & 7;
    dsa_task<false>(p, layer, bb * 8192 + c * 64 + sb2 * 8, bb * 8192, 0, (c + 1) * 64, smem); })
  if (sub & 2) WQ_LOOP(ctr + 32, NT_MA, t, { mixer_a_task(p, layer, t, smem); })
  if (sub & 1) WQ_LOOP(ctr + 48, NT_KV, t, { ret_kv_task(p, layer, t, smem); })
}
#undef WQ_LOOP

constexpr int NPHASE = 1 + 2 * 13;

__device__ __forceinline__ void run_phase(const P& p, int ph, unsigned char* smem, const bool dry, int* s_task) {
  if (ph == 0) { prep_phase(p, smem); return; }
  const int layer = (ph - 1) / 13, k = (ph - 1) % 13;
  if (k == 0 || k == 4 || k == 6 || k == 9 || k == 8 || k == 10 || k == 11) {
    int epi, NTN, mtiles, mt_base = 0, slab = -1, lda, K; const u16 *A, *Bt;
    if (k == 0) { epi = EPI_IN; NTN = DPJP / 128; mtiles = NR / 128; A = p.xb; lda = DM; K = DM; Bt = p.WinT + (size_t)layer * DPJP * DM; }
    else if (k == 4) { epi = EPI_OUT; NTN = 8; mtiles = NR / 128; A = p.mix; lda = DM; K = DM; Bt = p.WoutT + (size_t)layer * DM * DM; }
    else if (k == 6 || k == 9) { epi = EPI_GU; NTN = 44; slab = (k == 6) ? 0 : 1; mtiles = (k == 6) ? 68 : 64; A = p.xb; lda = DM; K = DM; Bt = p.WguT + (size_t)layer * 2 * DFF * DM; }
    else { epi = EPI_DOWN; NTN = 8; slab = (k == 11) ? 1 : 0; mtiles = (k == 10) ? 4 : 64; mt_base = (k == 10) ? 64 : 0; A = p.hu; lda = DFF; K = DFF; Bt = p.WdT + (size_t)layer * DM * DFF; }
    const int xcd = blockIdx.x & 7, jloc = blockIdx.x >> 3, nloc = gridDim.x >> 3;
    const int T = mtiles * NTN;
    const int u0 = (int)(((long)T * xcd) >> 3), u1 = (int)(((long)T * (xcd + 1)) >> 3);
    for (int u = u0 + jloc; u < u1; u += nloc) {
      const int sr = u / (8 * NTN);
      const int v = u - sr * 8 * NTN;
      const int Mr = (mtiles - sr * 8) < 8 ? (mtiles - sr * 8) : 8;
      const int nt = v / Mr, mi = v - nt * Mr;
      const int mtl = mt_base + sr * 8 + mi;
      const int hrow0 = mtl * 128;
      const int grow0 = (slab == 0) ? (mtl < 64 ? hrow0 : NPR + (mtl - 64) * 128) : (slab == 1 ? 8192 + hrow0 : hrow0);
      const u16* At = (epi == EPI_DOWN) ? A + (size_t)hrow0 * lda : A + (size_t)grow0 * lda;
      gemm_tile(p, epi, layer, grow0 - hrow0, At, lda, Bt + (size_t)nt * 128 * K, K, K, grow0, nt * 128, smem, dry);
    }
    if (k == 10) act_phase(p, layer, 1, 8192, dry, 32);
    return;
  }
  switch (k) {
    case 1: mix1_phase(p, layer, smem, 15, s_task); break;
    case 2: scan_phase(p, layer, dry);
      if (!dry && gridDim.x > 192) for (int t = 1536 + ((int)blockIdx.x - 192); t >= 1536 && t < NT_KV; t += gridDim.x - 192) ret_out_task(p, layer, t, smem);
      break;
    case 3: for (int t = blockIdx.x; t < (gridDim.x > 192 ? 1536 : NT_KV); t += gridDim.x) ret_out_task(p, layer, t, smem); break;
    case 5: ln_phase(p, p.ln1_g + layer * DM, p.ln1_b + layer * DM, dry, false, true, p.zb1); break;
    case 7: act_phase(p, layer, 0, 8704, dry, 0); break;
    case 12: ln_phase(p, p.ln2_g + layer * DM, p.ln2_b + layer * DM, dry, layer == 1, layer == 0, p.zb2); break;
  }
}

__global__ void __launch_bounds__(256, 2) mega(P p, int ph0, int ph1, int dryflag) {
  __shared__ __attribute__((aligned(16))) unsigned char smem[73728];
  __shared__ uint4 xb_words;
  __shared__ int s_task[2];
  if (threadIdx.x == 0) xb_words = make_uint4(0u, 0u, 0u, 0u);
  __syncthreads();
  XcdBarrier xb = xcd_barrier_post(p.bar, (volatile LAS unsigned*)&xb_words);
  if (ph1 < 0) cg::this_grid().sync();
  for (int ph = ph0; ph < ph1; ++ph) {
    run_phase(p, ph, smem, false, s_task);
#if PROBE_MASK
    if (ph > 0 && ((PROBE_MASK >> ((ph - 1) % 13)) & 1)) run_phase(p, ph, smem, dryflag != 0, s_task);
    if (ph > 0 && ((ph - 1) % 13) == 1 && (PROBE_MASK >> 13)) mix1_phase(p, (ph - 1) / 13, smem, (PROBE_MASK >> 13) & (14 + dryflag), s_task);
#endif
    if (ph + 1 < ph1) xcd_barrier(xb);
  }
}

extern "C" void kernel_launch(void* const* d_in, const int* in_sizes, int n_in, void* d_out, int out_size, void* d_ws,
                              size_t ws_size, hipStream_t stream) {
  P p{};
  p.x_prompt = (const float*)d_in[0]; p.x_sample = (const float*)d_in[1]; p.cache_k = (const float*)d_in[2];
  p.cache_v = (const float*)d_in[3]; p.cache_ki = (const float*)d_in[4]; p.state_ret = (const float*)d_in[5];
  p.state_conv = (const float*)d_in[6]; p.w_in = (const float*)d_in[7]; p.a_ln_g = (const float*)d_in[8];
  p.a_ln_b = (const float*)d_in[9]; p.a_ws = (const float*)d_in[10]; p.a_bs = (const float*)d_in[11];
  p.c_gn_g = (const float*)d_in[12]; p.w_out = (const float*)d_in[13]; p.ln1_g = (const float*)d_in[14];
  p.ln1_b = (const float*)d_in[15]; p.w_gate = (const float*)d_in[16]; p.w_up = (const float*)d_in[17];
  p.conv_w = (const float*)d_in[18]; p.conv_b = (const float*)d_in[19]; p.w_down = (const float*)d_in[20];
  p.ln2_g = (const float*)d_in[21]; p.ln2_b = (const float*)d_in[22];
  p.out = (float*)d_out;
  unsigned char* ws = (unsigned char*)d_ws;
  size_t o = 0;
  p.WinT = (u16*)(ws + o);  o += 2ull * DPJP * DM * 2;
  p.WoutT = (u16*)(ws + o); o += 2ull * DM * DM * 2;
  p.WguT = (u16*)(ws + o);  o += 2ull * 2 * DFF * DM * 2;
  p.WdT = (u16*)(ws + o);   o += 2ull * DM * DFF * 2;
  p.rope = (float*)(ws + o); o += 8192ull * 32 * 2 * 4;
  p.xb = (u16*)(ws + o);    o += (size_t)NR * DM * 2;
  unsigned char* big = ws + o;
  p.proj = (u16*)big;
  p.mix = (u16*)(big + (size_t)NR * DPJ * 2);
  p.kvbuf = (float*)(big + (size_t)NR * DPJ * 2 + (size_t)NR * DM * 2);
  p.hg = (u16*)big;
  p.hu = (u16*)(big + 8704ull * DFF * 2);
  p.zb1 = (u16*)big;
  p.zb2 = (u16*)(big + (100ull << 20));
  p.bar = (unsigned*)(ws + (250ull << 20));
  p.kic = (u16*)(ws + (233ull << 20)); p.kc = (u16*)(ws + (235ull << 20)); p.vc = (u16*)(ws + (238ull << 20));
  hipMemsetAsync(p.bar, 0, WQ_WORDS * 4, stream);

  static int grid_blocks = 0;
  if (!grid_blocks) {
    int dev = 0, cus = 0, per_cu = 0;
    hipGetDevice(&dev);
    hipDeviceGetAttribute(&cus, hipDeviceAttributeMultiprocessorCount, dev);
    hipOccupancyMaxActiveBlocksPerMultiprocessor(&per_cu, mega, 256, 0);
    if (per_cu > 2) per_cu = 2;
    if (per_cu < 1) per_cu = 1;
    grid_blocks = cus * per_cu;
  }
#if MULTI
  for (int ph = 0; ph < NPHASE; ++ph) {
    hipLaunchKernelGGL(mega, dim3(grid_blocks), dim3(256), 0, stream, p, ph, ph + 1, 1);
  }
#else
  int ph0 = 0, ph1 = NPHASE, dryflag = 1;
  void* args[] = {&p, &ph0, &ph1, &dryflag};
  hipError_t e = hipLaunchCooperativeKernel((void*)mega, dim3(grid_blocks), dim3(256), args, 0, stream);
  if (e != hipSuccess) fprintf(stderr, "cooperative launch failed: %s (grid %d)\n", hipGetErrorString(e), grid_blocks);
#endif
}
```

```cpp
#include <hip/hip_runtime.h>
#include <hip/hip_cooperative_groups.h>
#include <cstdio>
namespace cg = cooperative_groups;

#ifndef MULTI
#define MULTI 0
#endif
#ifndef PROBE_MASK
#define PROBE_MASK 0
#endif

typedef unsigned short u16;
typedef unsigned int u32;
typedef __attribute__((ext_vector_type(8))) short bf16x8;
typedef __attribute__((ext_vector_type(4))) float f32x4;
typedef __attribute__((ext_vector_type(16))) float f32x16;

constexpr int NPR = 16384, NSR = 512, NR = 16896;
constexpr int DM = 1024, DPJ = 2856, DPJP = 2944, DFF = 2816;
constexpr int C_UA = 0, C_VA = 256, C_QB = 512, C_KB = 896, C_VB = 960, C_QI = 1024, C_KI = 1280,
              C_WI = 1312, C_QC = 1320, C_KC = 1704, C_VC = 2088, C_GC = 2472;
constexpr float ALPHA = 1.4142135623730951f;

constexpr size_t OFF_Y   = 0;
constexpr size_t OFF_KP  = (size_t)NR * DM;
constexpr size_t OFF_VP  = OFF_KP + 2ull * 2 * 8192 * 64;
constexpr size_t OFF_KIP = OFF_VP + 2ull * 2 * 8192 * 64;
constexpr size_t OFF_RP  = OFF_KIP + 2ull * 2 * 8192 * 32;
constexpr size_t OFF_CP  = OFF_RP + 2ull * 2 * 6 * 4096;
constexpr size_t OFF_KS  = OFF_CP + 2ull * 2 * 2 * DFF;
constexpr size_t OFF_VS  = OFF_KS + 2ull * 32 * 16 * 64;
constexpr size_t OFF_KIS = OFF_VS + 2ull * 32 * 16 * 64;
constexpr size_t OFF_RS  = OFF_KIS + 2ull * 32 * 16 * 32;
constexpr size_t OFF_CS  = OFF_RS + 2ull * 32 * 6 * 4096;
constexpr size_t OFF_AV  = OFF_CS + 2ull * 32 * 2 * DFF;

struct P {
  const float *x_prompt, *x_sample, *cache_k, *cache_v, *cache_ki, *state_ret, *state_conv;
  const float *w_in, *a_ln_g, *a_ln_b, *a_ws, *a_bs, *c_gn_g, *w_out, *ln1_g, *ln1_b;
  const float *w_gate, *w_up, *conv_w, *conv_b, *w_down, *ln2_g, *ln2_b;
  float* out;
  u16 *WinT, *WoutT, *WguT, *WdT, *xb, *proj, *mix, *hg, *hu;
  float *rope, *kvbuf;
  unsigned* bar;
  u16 *kic, *kc, *vc;
  u16 *zb1, *zb2;
};

__constant__ double FREQ_REV[32] = {
0.15915494309189535, 0.11934937021124886, 0.08949940160889101, 0.06711508300522726, 0.050329212104487035, 0.03774158471741977, 0.0283021958306234, 0.02122365276477766, 0.015915494309189534, 0.011934937021124886, 0.008949940160889102, 0.006711508300522725, 0.005032921210448704, 0.003774158471741977, 0.00283021958306234, 0.0021223652764777662, 0.0015915494309189536, 0.0011934937021124885, 0.0008949940160889102, 0.0006711508300522726, 0.0005032921210448703, 0.00037741584717419774, 0.00028302195830623395, 0.0002122365276477766, 0.00015915494309189535, 0.00011934937021124886, 8.949940160889102e-05, 6.711508300522725e-05, 5.0329212104487035e-05, 3.774158471741978e-05, 2.8302195830623396e-05, 2.122365276477766e-05};

__device__ __forceinline__ u16 f2bf(float f) { __bf16 h = (__bf16)f; return __builtin_bit_cast(u16, h); }
__device__ __forceinline__ float bf2f(u32 h) { return __uint_as_float(h << 16); }
typedef __bf16 bf2_t __attribute__((ext_vector_type(2)));
typedef float fl2_t __attribute__((ext_vector_type(2)));
typedef short s2_t __attribute__((ext_vector_type(2)));
__device__ __forceinline__ u32 pack2(float a, float b) { fl2_t f = {a, b}; bf2_t h = __builtin_convertvector(f, bf2_t); return __builtin_bit_cast(u32, h); }
__device__ __forceinline__ u32 pack2_relu(float a, float b) { u32 v = pack2(a, b); s2_t s = __builtin_bit_cast(s2_t, v); s2_t z = {0, 0}; s = __builtin_elementwise_max(s, z); return __builtin_bit_cast(u32, s); }
__device__ __forceinline__ float bflo(u32 w) { return __uint_as_float(w << 16); }
__device__ __forceinline__ float bfhi(u32 w) { return __uint_as_float(w & 0xffff0000u); }
__device__ __forceinline__ float gelu_f(float x) { float t = 1.5957691216f * (x + 0.044715f * x * x * x); return x / (1.f + __expf(-t)); }
__device__ __forceinline__ float silu_f(float x) { return x / (1.f + __expf(-x)); }
__device__ __forceinline__ bf16x8 pack8(float4 a, float4 b) {
  uint4 r; r.x = pack2(a.x, a.y); r.y = pack2(a.z, a.w); r.z = pack2(b.x, b.y); r.w = pack2(b.z, b.w);
  return __builtin_bit_cast(bf16x8, r);
}
__device__ __forceinline__ f32x4 mfma16(bf16x8 a, bf16x8 b, f32x4 c) { return __builtin_amdgcn_mfma_f32_16x16x32_bf16(a, b, c, 0, 0, 0); }
__device__ __forceinline__ f32x16 mfma32(bf16x8 a, bf16x8 b, f32x16 c) { return __builtin_amdgcn_mfma_f32_32x32x16_bf16(a, b, c, 0, 0, 0); }
__device__ __forceinline__ int TID() { int t = threadIdx.x; asm volatile("" : "+v"(t)); return t; }
__device__ __forceinline__ float head_lg(int h) { return logf(1.0f - exp2f(-5.0f - (float)h)); }


#define XB_TMO      128
#define XB_XCNT(j)  (256  + 64 * (j))
#define XB_XSUB(j)  (1280 + 64 * (j))
#define XB_XGEN(j)  (2304 + 64 * (j))
#define XB_TOP      3328
#define XB_TOPGEN   3392
#define XCD_BAR_WORDS 3456
#define XB_SPIN_CAP (1u << 22)
#define LAS __attribute__((address_space(3)))
__device__ __forceinline__ unsigned xb_ld(unsigned* p)              { return __hip_atomic_load(p, __ATOMIC_RELAXED, __HIP_MEMORY_SCOPE_AGENT); }
__device__ __forceinline__ unsigned xb_add(unsigned* p, unsigned v) { return __hip_atomic_fetch_add(p, v, __ATOMIC_RELAXED, __HIP_MEMORY_SCOPE_AGENT); }
__device__ __forceinline__ unsigned xb_xcc_id() { return (unsigned)__builtin_amdgcn_s_getreg((3 << 11) | 20) & 0xFu; }
#define XB_SPIN(cond, bar) do { unsigned _sp = 0; while (cond) { __builtin_amdgcn_s_sleep(1); \
    if ((++_sp & 255u) == 0u) { if (xb_ld(&(bar)[XB_TMO])) break; if (_sp > XB_SPIN_CAP) { atomicAdd(&(bar)[XB_TMO], 1u); break; } } } } while (0)
struct XcdBarrier { unsigned* bar; unsigned x; volatile LAS unsigned* st; };
__device__ __forceinline__ XcdBarrier xcd_barrier_post(unsigned* bar, volatile LAS unsigned* st) {
    XcdBarrier b; b.bar = bar; b.x = xb_xcc_id(); b.st = st;
    if (threadIdx.x == 0) (void)xb_add(&bar[XB_XCNT(b.x)], 1u);
    return b;
}
__device__ __forceinline__ void xcd_barrier_complete(unsigned* bar, unsigned x, unsigned& nloc, unsigned& nx) {
    const unsigned G = gridDim.x * gridDim.y * gridDim.z;
    unsigned sum, cnt, mine, sp = 0u;
    for (;;) {
        sum = 0u; cnt = 0u; mine = 0u;
#pragma unroll
        for (unsigned j = 0; j < 16; ++j) { const unsigned c = xb_ld(&bar[XB_XCNT(j)]); sum += c; cnt += (c > 0u) ? 1u : 0u; mine = (j == x) ? c : mine; }
        if (sum == G) break;
        __builtin_amdgcn_s_sleep(1);
        if ((++sp & 255u) == 0u) { if (xb_ld(&bar[XB_TMO])) break; if (sp > XB_SPIN_CAP) { atomicAdd(&bar[XB_TMO], 1u); break; } }
    }
    nloc = mine > 0u ? mine : 1u; nx = cnt > 0u ? cnt : 1u;
}
__device__ __forceinline__ void xcd_barrier(const XcdBarrier& b) {
    asm volatile("s_waitcnt vmcnt(0)" ::: "memory");
    __syncthreads();
    if (threadIdx.x == 0) {
        unsigned* bar = b.bar;
        __builtin_amdgcn_s_waitcnt(0);
        unsigned nloc = b.st[0], nx = b.st[1];
        if (nloc == 0u) { xcd_barrier_complete(bar, b.x, nloc, nx); b.st[0] = nloc; b.st[1] = nx; }
        const unsigned old = xb_add(&bar[XB_XSUB(b.x)], 1u);
        const unsigned gen = old / nloc;
        if (old + 1u == (gen + 1u) * nloc) {
            __builtin_amdgcn_fence(__ATOMIC_RELEASE, "agent");
            asm volatile("s_waitcnt vmcnt(0)" ::: "memory");
            const unsigned og = xb_add(&bar[XB_TOP], 1u);
            const unsigned tg = og / nx;
            if (og + 1u == (tg + 1u) * nx) xb_add(&bar[XB_TOPGEN], 1u);
            else XB_SPIN(xb_ld(&bar[XB_TOPGEN]) == tg, bar);
            __builtin_amdgcn_fence(__ATOMIC_ACQUIRE, "agent");
            xb_add(&bar[XB_XGEN(b.x)], 1u);
            asm volatile("s_waitcnt vmcnt(0)" ::: "memory");
        } else {
            XB_SPIN(xb_ld(&bar[XB_XGEN(b.x)]) == gen, bar);
            __builtin_amdgcn_fence(__ATOMIC_ACQUIRE, "agent");
            asm volatile("s_waitcnt vmcnt(0)" ::: "memory");
        }
    }
    __syncthreads();
}

__device__ __forceinline__ void transpose_tile(const float* __restrict__ W, int K, int N, u16* __restrict__ Wt, int k0, int n0, float* tile) {
  const int tid = TID();
#pragma unroll
  for (int i = 0; i < 4; ++i) {
    int idx = tid + i * 256; int kr = idx >> 4, c4 = (idx & 15) * 4; int n = n0 + c4;
    float4 v = make_float4(0.f, 0.f, 0.f, 0.f);
    if (n < N) v = *(const float4*)(W + (size_t)(k0 + kr) * N + n);
    float* t = tile + kr * 65 + c4; t[0] = v.x; t[1] = v.y; t[2] = v.z; t[3] = v.w;
  }
  __syncthreads();
#pragma unroll
  for (int i = 0; i < 2; ++i) {
    int idx = tid + i * 256; int j = idx >> 3, c = (idx & 7) * 8;
    uint4 r;
    r.x = pack2(tile[(c + 0) * 65 + j], tile[(c + 1) * 65 + j]);
    r.y = pack2(tile[(c + 2) * 65 + j], tile[(c + 3) * 65 + j]);
    r.z = pack2(tile[(c + 4) * 65 + j], tile[(c + 5) * 65 + j]);
    r.w = pack2(tile[(c + 6) * 65 + j], tile[(c + 7) * 65 + j]);
    *(uint4*)(Wt + (size_t)(n0 + j) * K + k0 + c) = r;
  }
  __syncthreads();
}

__device__ __forceinline__ void tt_load(const float* __restrict__ W, int N, int k0, int n0, int tid, float4* v) {
#pragma unroll
  for (int i = 0; i < 4; ++i) {
    int idx = tid + i * 256; int kr = idx >> 4, c4 = (idx & 15) * 4; int n = n0 + c4;
    v[i] = make_float4(0.f, 0.f, 0.f, 0.f);
    if (n < N) v[i] = *(const float4*)(W + (size_t)(k0 + kr) * N + n);
  }
}
__device__ __forceinline__ void tt_lds(const float4* v, int tid, float* tile) {
#pragma unroll
  for (int i = 0; i < 4; ++i) {
    int idx = tid + i * 256; int kr = idx >> 4, c4 = (idx & 15) * 4;
    float* t = tile + kr * 65 + c4; t[0] = v[i].x; t[1] = v[i].y; t[2] = v[i].z; t[3] = v[i].w;
  }
}
__device__ __forceinline__ void tt_out(u16* __restrict__ Wt, int K, int k0, int n0, int tid, const float* tile) {
#pragma unroll
  for (int i = 0; i < 2; ++i) {
    int idx = tid + i * 256; int j = idx >> 3, c = (idx & 7) * 8;
    uint4 r;
    r.x = pack2(tile[(c + 0) * 65 + j], tile[(c + 1) * 65 + j]);
    r.y = pack2(tile[(c + 2) * 65 + j], tile[(c + 3) * 65 + j]);
    r.z = pack2(tile[(c + 4) * 65 + j], tile[(c + 5) * 65 + j]);
    r.w = pack2(tile[(c + 6) * 65 + j], tile[(c + 7) * 65 + j]);
    *(uint4*)(Wt + (size_t)(n0 + j) * K + k0 + c) = r;
  }
}
struct TDesc { const float* W; u16* Wt; int K, N, k0, n0; };
__device__ __forceinline__ TDesc tt_decode(const P& p, int t);

constexpr int PT_WIN = 16 * 46, PT_WOUT = 256, PT_WG = 16 * 44, PT_WD = 44 * 16;
constexpr int PT_LAYER = PT_WIN + PT_WOUT + 2 * PT_WG + PT_WD;
constexpr int PT_X = NR * DM / 8192;
constexpr int PT_ROPE = 256;
constexpr int PT_TOTAL = 2 * PT_LAYER + PT_X + PT_ROPE;

__device__ __forceinline__ TDesc tt_decode(const P& p, int t) {
  TDesc d;
  int l = t / PT_LAYER, u = t % PT_LAYER;
  if (u < PT_WIN) { d.W = p.w_in + (size_t)l * DM * DPJ; d.K = DM; d.N = DPJ; d.Wt = p.WinT + (size_t)l * DPJP * DM; d.k0 = (u / 46) * 64; d.n0 = (u % 46) * 64; }
  else if ((u -= PT_WIN) < PT_WOUT) { d.W = p.w_out + (size_t)l * DM * DM; d.K = DM; d.N = DM; d.Wt = p.WoutT + (size_t)l * DM * DM; d.k0 = (u / 16) * 64; d.n0 = (u % 16) * 64; }
  else if ((u -= PT_WOUT) < PT_WG) { d.W = p.w_gate + (size_t)l * DM * DFF; d.K = DM; d.N = DFF; d.Wt = p.WguT + (size_t)l * 2 * DFF * DM; d.k0 = (u / 44) * 64; d.n0 = (u % 44) * 64; }
  else if ((u -= PT_WG) < PT_WG) { d.W = p.w_up + (size_t)l * DM * DFF; d.K = DM; d.N = DFF; d.Wt = p.WguT + (size_t)l * 2 * DFF * DM + (size_t)DFF * DM; d.k0 = (u / 44) * 64; d.n0 = (u % 44) * 64; }
  else { u -= PT_WG; d.W = p.w_down + (size_t)l * DFF * DM; d.K = DFF; d.N = DM; d.Wt = p.WdT + (size_t)l * DM * DFF; d.k0 = (u / 16) * 64; d.n0 = (u % 16) * 64; }
  return d;
}
__device__ __forceinline__ void prep_phase(const P& p, unsigned char* smem) {
  float* tile = (float*)smem;
  const int tid = TID();
  float* tile2 = tile + 64 * 65;
  for (int t = blockIdx.x; t < 2 * PT_LAYER; t += 2 * gridDim.x) {
    const TDesc a = tt_decode(p, t);
    const int t2 = t + gridDim.x;
    const bool hb = t2 < 2 * PT_LAYER;
    const TDesc b = tt_decode(p, hb ? t2 : t);
    float4 va[4], vb[4];
    tt_load(a.W, a.N, a.k0, a.n0, tid, va);
    if (hb) tt_load(b.W, b.N, b.k0, b.n0, tid, vb);
    tt_lds(va, tid, tile);
    if (hb) tt_lds(vb, tid, tile2);
    __syncthreads();
    tt_out(a.Wt, a.K, a.k0, a.n0, tid, tile);
    if (hb) tt_out(b.Wt, b.K, b.k0, b.n0, tid, tile2);
    __syncthreads();
  }
  for (int t = 2 * PT_LAYER + blockIdx.x; t < PT_TOTAL; t += gridDim.x) {
    if (false) {
    } else if (t < 2 * PT_LAYER + PT_X) {
      int u = t - 2 * PT_LAYER;
#pragma unroll
      for (int i = 0; i < 4; ++i) {
        size_t idx = ((size_t)u * 1024 + i * 256 + tid) * 8;
        const float* src = idx < (size_t)NPR * DM ? p.x_prompt + idx : p.x_sample + (idx - (size_t)NPR * DM);
        float4 a = ((const float4*)src)[0], b = ((const float4*)src)[1];
        *(bf16x8*)(p.xb + idx) = pack8(a, b);
      }
    } else {
      int u = t - 2 * PT_LAYER - PT_X;
#pragma unroll
      for (int i = 0; i < 4; ++i) {
        int e = u * 1024 + i * 256 + tid; int pos = e >> 5, ii = e & 31;
        double rev = (double)pos * FREQ_REV[ii];
        rev -= floor(rev);
        float fr = (float)rev;
        float2 cs; cs.x = __builtin_amdgcn_cosf(fr); cs.y = __builtin_amdgcn_sinf(fr);
        *(float2*)(p.rope + (size_t)e * 2) = cs;
      }
    }
  }
}

enum { EPI_IN = 0, EPI_OUT = 1, EPI_GU = 2, EPI_DOWN = 3 };

__device__ __forceinline__ void gemm_tile(const P& p, const int EPI, int layer, int slab_row0, const u16* __restrict__ Atile, int lda,
                                          const u16* __restrict__ Btile, int ldb, int K, int m0, int n0, unsigned char* smem, const bool dry) {
  const int tid = TID(), lane = tid & 63, wid = tid >> 6;
  const int wr = wid >> 1, wc = wid & 1;
  const int grow = tid >> 3, gcol = (((tid & 7) ^ ((tid >> 4) & 7)) << 3);
  const u16* ap = Atile + (size_t)grow * lda + gcol;
  const u16* bp = Btile + (size_t)grow * ldb + gcol;
  f32x4 acc[4][4];
#pragma unroll
  for (int i = 0; i < 4; ++i)
#pragma unroll
    for (int j = 0; j < 4; ++j) acc[i][j] = (f32x4){0.f, 0.f, 0.f, 0.f};
  const int nk = K >> 6;
  const int swr = (lane & 15) >> 1, q4 = lane >> 4;
  const int aoff = (wr * 64 + (lane & 15)) * 128 + ((q4 ^ swr) << 4);
  const int boff = 16384 + (wc * 64 + (lane & 15)) * 128 + ((q4 ^ swr) << 4);
  typedef __attribute__((address_space(3))) unsigned lds_u32;
#define G_DMA1(I, KT, ST) __builtin_amdgcn_global_load_lds((const unsigned*)(ap + (size_t)I * 32 * lda + (KT) * 64), (lds_u32*)(smem + (ST) * 32768 + I * 4096 + tid * 16), 16, 0, 0); \
                          __builtin_amdgcn_global_load_lds((const unsigned*)(bp + (size_t)I * 32 * ldb + (KT) * 64), (lds_u32*)(smem + (ST) * 32768 + 16384 + I * 4096 + tid * 16), 16, 0, 0);
#define G_DMA(KT, ST) { G_DMA1(0, KT, ST) G_DMA1(1, KT, ST) G_DMA1(2, KT, ST) G_DMA1(3, KT, ST) }
  const unsigned lbase = (unsigned)(size_t)((__attribute__((address_space(3))) unsigned char*)smem);
  const unsigned aad0 = lbase + aoff, aad1 = lbase + (aoff ^ 64), bad0 = lbase + boff, bad1 = lbase + (boff ^ 64);
#define LDSR(DST, ADDR, OFF) asm volatile("ds_read_b128 %0, %1 offset:%2" : "=v"(DST) : "v"(ADDR), "n"(OFF))
#define LWAIT8(A, B) asm volatile("s_waitcnt lgkmcnt(0)" : "+v"(A[0]), "+v"(A[1]), "+v"(A[2]), "+v"(A[3]), "+v"(B[0]), "+v"(B[1]), "+v"(B[2]), "+v"(B[3]) :: "memory")
#define G_COMPUTE(BUF) { bf16x8 af0[4], bf0[4], af1[4], bf1[4]; \
      LDSR(af0[0], aad0, (BUF) * 32768 + 0); LDSR(af0[1], aad0, (BUF) * 32768 + 2048); LDSR(af0[2], aad0, (BUF) * 32768 + 4096); LDSR(af0[3], aad0, (BUF) * 32768 + 6144); \
      LDSR(bf0[0], bad0, (BUF) * 32768 + 0); LDSR(bf0[1], bad0, (BUF) * 32768 + 2048); LDSR(bf0[2], bad0, (BUF) * 32768 + 4096); LDSR(bf0[3], bad0, (BUF) * 32768 + 6144); \
      LWAIT8(af0, bf0); \
      LDSR(af1[0], aad1, (BUF) * 32768 + 0); LDSR(af1[1], aad1, (BUF) * 32768 + 2048); LDSR(af1[2], aad1, (BUF) * 32768 + 4096); LDSR(af1[3], aad1, (BUF) * 32768 + 6144); \
      LDSR(bf1[0], bad1, (BUF) * 32768 + 0); LDSR(bf1[1], bad1, (BUF) * 32768 + 2048); LDSR(bf1[2], bad1, (BUF) * 32768 + 4096); LDSR(bf1[3], bad1, (BUF) * 32768 + 6144); \
      __builtin_amdgcn_s_setprio(1); \
      _Pragma("unroll") for (int i = 0; i < 4; ++i) _Pragma("unroll") for (int j = 0; j < 4; ++j) acc[i][j] = mfma16(bf0[j], af0[i], acc[i][j]); \
      LWAIT8(af1, bf1); \
      _Pragma("unroll") for (int i = 0; i < 4; ++i) _Pragma("unroll") for (int j = 0; j < 4; ++j) acc[i][j] = mfma16(bf1[j], af1[i], acc[i][j]); \
      __builtin_amdgcn_s_setprio(0); }
  G_DMA(0, 0);
  __syncthreads();
  for (int kt = 0; kt < nk; kt += 2) {
    G_DMA(kt + 1, 1);
    G_COMPUTE(0);
    __syncthreads();
    if (kt + 2 < nk) G_DMA(kt + 2, 0);
    G_COMPUTE(1);
    __syncthreads();
  }
#undef G_DMA
#undef G_DMA1
#undef G_COMPUTE
#undef LDSR
#undef LWAIT8
  if (dry) return;
#pragma unroll
  for (int mt = 0; mt < 4; ++mt) {
    const int row = m0 + wr * 64 + mt * 16 + (lane & 15);
#pragma unroll
    for (int nt = 0; nt < 4; ++nt) {
      const int col = n0 + wc * 64 + nt * 16 + (lane >> 4) * 4;
      f32x4 a = acc[mt][nt];
      if (EPI == EPI_IN) {
        if (col < DPJ) {
          uint2 pk; pk.x = pack2(a[0], a[1]); pk.y = pack2(a[2], a[3]);
          *(uint2*)(p.proj + (size_t)row * DPJ + col) = pk;
          if (col >= C_KB && col < C_QI) {
            bool isv = col >= C_VB; int cc = col - (isv ? C_VB : C_KB);
            float* dst = (row < NPR) ? p.out + (isv ? OFF_VP : OFF_KP) + ((size_t)layer * NPR + row) * 64 + cc
                                     : p.out + (isv ? OFF_VS : OFF_KS) + ((size_t)layer * NSR + (row - NPR)) * 64 + cc;
            *(float4*)dst = make_float4(a[0], a[1], a[2], a[3]);
            *(uint2*)((isv ? p.vc : p.kc) + (size_t)row * 64 + cc) = pk;
          } else if (col >= C_KI && col < C_WI) {
            int cc = col - C_KI;
            *(uint2*)(p.kic + (size_t)row * 32 + cc) = pk;
            float* dst = (row < NPR) ? p.out + OFF_KIP + ((size_t)layer * NPR + row) * 32 + cc
                                     : p.out + OFF_KIS + ((size_t)layer * NSR + (row - NPR)) * 32 + cc;
            *(float4*)dst = make_float4(a[0], a[1], a[2], a[3]);
          }
        }
      } else if (EPI == EPI_OUT) {
        float4 xv;
        if (layer == 0) {
          const float* xin = row < NPR ? p.x_prompt + (size_t)row * DM : p.x_sample + (size_t)(row - NPR) * DM;
          xv = *(const float4*)(xin + col);
        } else {
          uint2 xr = *(const uint2*)(p.xb + (size_t)row * DM + col);
          xv = make_float4(bflo(xr.x), bfhi(xr.x), bflo(xr.y), bfhi(xr.y));
        }
        { uint2 zk; zk.x = pack2(ALPHA * xv.x + a[0], ALPHA * xv.y + a[1]); zk.y = pack2(ALPHA * xv.z + a[2], ALPHA * xv.w + a[3]);
          *(uint2*)(p.zb1 + (size_t)row * DM + col) = zk; }
      } else if (EPI == EPI_GU) {
        const int hrow = row - slab_row0;
        uint2 pk; pk.x = pack2(a[0], a[1]); pk.y = pack2(a[2], a[3]);
        if (col < DFF) {
          *(uint2*)(p.hg + (size_t)hrow * DFF + col) = pk;
          if (row < NPR) {
            int t = row & 8191;
            if (t >= 8190) *(float4*)(p.out + OFF_CP + ((size_t)(layer * 2 + (row >> 13)) * 2 + (t - 8190)) * DFF + col) = make_float4(a[0], a[1], a[2], a[3]);
          } else {
            int rs = row - NPR, t = rs & 15;
            if (t >= 14) *(float4*)(p.out + OFF_CS + ((size_t)(layer * 32 + (rs >> 4)) * 2 + (t - 14)) * DFF + col) = make_float4(a[0], a[1], a[2], a[3]);
          }
        } else {
          *(uint2*)(p.hu + (size_t)hrow * DFF + (col - DFF)) = pk;
        }
      } else {
        uint2 xr = *(const uint2*)(p.xb + (size_t)row * DM + col);
        uint2 zk; zk.x = pack2(ALPHA * bflo(xr.x) + a[0], ALPHA * bfhi(xr.x) + a[1]); zk.y = pack2(ALPHA * bflo(xr.y) + a[2], ALPHA * bfhi(xr.y) + a[3]);
        *(uint2*)(p.zb2 + (size_t)row * DM + col) = zk;
      }
    }
  }
}

__device__ __forceinline__ void ln_phase(const P& p, const float* __restrict__ g, const float* __restrict__ b, const bool dry, const bool wr_f32, const bool wr_bf16, const u16* __restrict__ zsrc) {
  const int tid_ = TID(); const int lane = tid_ & 63, wid = tid_ >> 6;
  for (int t = blockIdx.x; t < NR / 16; t += gridDim.x) {
    float4 v[4][4];
#pragma unroll
    for (int rr = 0; rr < 4; ++rr) {
      const u16* zr = zsrc + (size_t)(t * 16 + wid * 4 + rr) * DM;
#pragma unroll
      for (int i = 0; i < 4; ++i) { uint2 zz = *(const uint2*)(zr + i * 256 + lane * 4); v[rr][i] = make_float4(bflo(zz.x), bfhi(zz.x), bflo(zz.y), bfhi(zz.y)); }
    }
#pragma unroll
    for (int rr = 0; rr < 4; ++rr) {
      const int row = t * 16 + wid * 4 + rr;
      float* xr = p.out + (size_t)row * DM;
      float s = 0.f;
#pragma unroll
      for (int i = 0; i < 4; ++i) s += v[rr][i].x + v[rr][i].y + v[rr][i].z + v[rr][i].w;
#pragma unroll
      for (int o = 1; o < 64; o <<= 1) s += __shfl_xor(s, o);
      const float mean = s * (1.f / 1024.f);
      float q = 0.f;
#pragma unroll
      for (int i = 0; i < 4; ++i) { float a = v[rr][i].x - mean, bb = v[rr][i].y - mean, c = v[rr][i].z - mean, d = v[rr][i].w - mean; q += a * a + bb * bb + c * c + d * d; }
#pragma unroll
      for (int o = 1; o < 64; o <<= 1) q += __shfl_xor(q, o);
      const float rstd = rsqrtf(q * (1.f / 1024.f) + 1e-5f);
      if (!dry) {
#pragma unroll
        for (int i = 0; i < 4; ++i) {
          const int c = i * 256 + lane * 4;
          float4 gg = *(const float4*)(g + c), bb = *(const float4*)(b + c);
          float4 y;
          y.x = (v[rr][i].x - mean) * rstd * gg.x + bb.x; y.y = (v[rr][i].y - mean) * rstd * gg.y + bb.y;
          y.z = (v[rr][i].z - mean) * rstd * gg.z + bb.z; y.w = (v[rr][i].w - mean) * rstd * gg.w + bb.w;
          if (wr_f32) *(float4*)(xr + c) = y;
          if (wr_bf16) { uint2 pk; pk.x = pack2(y.x, y.y); pk.y = pack2(y.z, y.w); *(uint2*)(p.xb + (size_t)row * DM + c) = pk; }
        }
      }
    }
  }
}

__device__ __forceinline__ void unpack8(uint4 a, float* f) {
  f[0] = bflo(a.x); f[1] = bfhi(a.x); f[2] = bflo(a.y); f[3] = bfhi(a.y); f[4] = bflo(a.z); f[5] = bfhi(a.z); f[6] = bflo(a.w); f[7] = bfhi(a.w);
}
__device__ __forceinline__ void act_phase(const P& p, int layer, int slab, int slab_rows, const bool dry, const int bskip) {
  const int tid = TID();
  const int nitems = (slab_rows / 8) * (DFF / 8);
  const int ntask = (nitems + 255) / 256;
  const float* cw = p.conv_w + (size_t)layer * 3 * DFF;
  const float* cb = p.conv_b + (size_t)layer * DFF;
  if ((int)blockIdx.x < bskip) return;
  for (int t = blockIdx.x - bskip; t < ntask; t += gridDim.x - bskip) {
    const int item = t * 256 + tid;
    if (item < nitems) {
      const int rg = item / (DFF / 8), cc = item % (DFF / 8);
      const int c0 = cc * 8;
      const int hrow0 = rg * 8;
      const int row0 = (slab == 0) ? (hrow0 < 8192 ? hrow0 : NPR + (hrow0 - 8192)) : 8192 + hrow0;
      const int tt = (row0 < NPR) ? (row0 & 8191) : ((row0 - NPR) & 15);
      uint4 hgv[8], huv[8];
#pragma unroll
      for (int r = 0; r < 8; ++r) { hgv[r] = *(const uint4*)(p.hg + (size_t)(hrow0 + r) * DFF + c0); huv[r] = *(const uint4*)(p.hu + (size_t)(hrow0 + r) * DFF + c0); }
      float h1[8], h2[8];
      if (tt == 0) {
        if (row0 < NPR) {
#pragma unroll
          for (int e = 0; e < 8; ++e) { h1[e] = 0.f; h2[e] = 0.f; }
        } else {
          const float* st = p.state_conv + ((size_t)(layer * 32 + ((row0 - NPR) >> 4)) * 2) * DFF + c0;
#pragma unroll
          for (int e = 0; e < 8; ++e) { h2[e] = st[e]; h1[e] = st[DFF + e]; }
        }
      } else {
        unpack8(*(const uint4*)(p.hg + (size_t)(hrow0 - 1) * DFF + c0), h1);
        unpack8(*(const uint4*)(p.hg + (size_t)(hrow0 - 2) * DFF + c0), h2);
      }
      float w0[8], w1[8], w2[8], bb[8];
#pragma unroll
      for (int e = 0; e < 8; ++e) { w0[e] = cw[c0 + e]; w1[e] = cw[DFF + c0 + e]; w2[e] = cw[2 * DFF + c0 + e]; bb[e] = cb[c0 + e]; }
#pragma unroll
      for (int r = 0; r < 8; ++r) {
        float h0[8], uu[8], o[8];
        unpack8(hgv[r], h0); unpack8(huv[r], uu);
#pragma unroll
        for (int e = 0; e < 8; ++e) {
          float cv = bb[e] + w0[e] * h2[e] + w1[e] * h1[e] + w2[e] * h0[e];
          o[e] = gelu_f(cv) * uu[e];
          h2[e] = h1[e]; h1[e] = h0[e];
        }
        uint4 r4; r4.x = pack2(o[0], o[1]); r4.y = pack2(o[2], o[3]); r4.z = pack2(o[4], o[5]); r4.w = pack2(o[6], o[7]);
        if (!dry) *(uint4*)(p.hu + (size_t)(hrow0 + r) * DFF + c0) = r4;
      }
    }
  }
}

__device__ __forceinline__ void mixer_a_task(const P& p, int layer, int task, unsigned char* smem) {
  const int tid = TID(), lane = tid & 63, w = tid >> 6;
  int g, row0, CL, sb = 0; bool samp = false;
  if (task < 512) { g = task & 3; row0 = (task >> 2) * 128; CL = 128; }
  else { int ts = task - 512; g = ts & 3; sb = ts >> 2; row0 = NPR + sb * 16; CL = 16; samp = true; }
  u16* vnT = (u16*)smem;
  {
    const int r = tid >> 1, half = tid & 1;
    float v[32];
    if (r < CL) {
      const uint4* src = (const uint4*)(p.proj + (size_t)(row0 + r) * DPJ + C_VA + g * 64 + half * 32);
#pragma unroll
      for (int i = 0; i < 4; ++i) {
        uint4 a = src[i];
        v[i * 8 + 0] = gelu_f(bflo(a.x)); v[i * 8 + 1] = gelu_f(bfhi(a.x)); v[i * 8 + 2] = gelu_f(bflo(a.y)); v[i * 8 + 3] = gelu_f(bfhi(a.y));
        v[i * 8 + 4] = gelu_f(bflo(a.z)); v[i * 8 + 5] = gelu_f(bfhi(a.z)); v[i * 8 + 6] = gelu_f(bflo(a.w)); v[i * 8 + 7] = gelu_f(bfhi(a.w));
      }
    } else {
#pragma unroll
      for (int i = 0; i < 32; ++i) v[i] = 0.f;
    }
    float s = 0.f;
#pragma unroll
    for (int i = 0; i < 32; ++i) s += v[i];
    s += __shfl_xor(s, 1);
    const float mean = s * (1.f / 64.f);
    float q = 0.f;
#pragma unroll
    for (int i = 0; i < 32; ++i) { float d = v[i] - mean; q += d * d; }
    q += __shfl_xor(q, 1);
    const float rstd = rsqrtf(q * (1.f / 64.f) + 1e-5f);
    const float* lg = p.a_ln_g + layer * 256 + g * 64 + half * 32;
    const float* lb = p.a_ln_b + layer * 256 + g * 64 + half * 32;
#pragma unroll
    for (int i = 0; i < 32; ++i) {
      float y = (r < CL) ? (v[i] - mean) * rstd * lg[i] + lb[i] : 0.f;
      v[i] = y;
      vnT[(half * 32 + i) * 136 + r] = f2bf(y);
    }
    if (samp && r < CL) {
      float* dst = p.out + OFF_AV + ((size_t)(layer * 32 + sb) * 16 + r) * 256 + g * 64 + half * 32;
#pragma unroll
      for (int i = 0; i < 8; ++i) *(float4*)(dst + i * 4) = make_float4(v[i * 4], v[i * 4 + 1], v[i * 4 + 2], v[i * 4 + 3]);
    }
  }
  __syncthreads();
  {
    const int i0 = w * 32;
    f32x4 acc[2][4];
#pragma unroll
    for (int i = 0; i < 2; ++i)
#pragma unroll
      for (int j = 0; j < 4; ++j) acc[i][j] = (f32x4){0.f, 0.f, 0.f, 0.f};
    const float* Wg = p.a_ws + (size_t)(layer * 4 + g) * 128 * 128;
    if (i0 < CL) {
      for (int ks = 0; ks < 4; ++ks) {
        if (ks * 32 > i0 + 31 || ks * 32 >= CL) break;
        bf16x8 bfr[4];
#pragma unroll
        for (int nt = 0; nt < 4; ++nt) bfr[nt] = *(const bf16x8*)(vnT + (nt * 16 + (lane & 15)) * 136 + ks * 32 + (lane >> 4) * 8);
#pragma unroll
        for (int mt = 0; mt < 2; ++mt) {
          const int i = i0 + mt * 16 + (lane & 15);
          const int j0 = ks * 32 + (lane >> 4) * 8;
          const float* wp = Wg + (size_t)i * 128 + j0;
          float4 a = ((const float4*)wp)[0], b = ((const float4*)wp)[1];
          a.x = (j0 + 0 <= i) ? a.x : 0.f; a.y = (j0 + 1 <= i) ? a.y : 0.f; a.z = (j0 + 2 <= i) ? a.z : 0.f; a.w = (j0 + 3 <= i) ? a.w : 0.f;
          b.x = (j0 + 4 <= i) ? b.x : 0.f; b.y = (j0 + 5 <= i) ? b.y : 0.f; b.z = (j0 + 6 <= i) ? b.z : 0.f; b.w = (j0 + 7 <= i) ? b.w : 0.f;
          bf16x8 af = pack8(a, b);
#pragma unroll
          for (int nt = 0; nt < 4; ++nt) acc[mt][nt] = mfma16(bfr[nt], af, acc[mt][nt]);
        }
      }
#pragma unroll
      for (int mt = 0; mt < 2; ++mt) {
        const int i = i0 + mt * 16 + (lane & 15);
        if (i < CL) {
          const float bsv = p.a_bs[(layer * 4 + g) * 128 + i];
#pragma unroll
          for (int nt = 0; nt < 4; ++nt) {
            const int c = nt * 16 + (lane >> 4) * 4;
            uint2 u = *(const uint2*)(p.proj + (size_t)(row0 + i) * DPJ + C_UA + g * 64 + c);
            f32x4 a = acc[mt][nt];
            uint2 o;
            o.x = pack2(gelu_f(bflo(u.x)) * (a[0] + bsv), gelu_f(bfhi(u.x)) * (a[1] + bsv));
            o.y = pack2(gelu_f(bflo(u.y)) * (a[2] + bsv), gelu_f(bfhi(u.y)) * (a[3] + bsv));
            *(uint2*)(p.mix + (size_t)(row0 + i) * DM + g * 64 + c) = o;
          }
        }
      }
    }
  }
  __syncthreads();
}

__device__ __forceinline__ void ret_decode(int task, int& h, int& row0, int& CL, int& pos0, int& bidx, int& n, bool& samp) {
  if (task < 1536) { h = task % 6; int cn = task / 6; bidx = cn >> 7; n = cn & 127; row0 = cn * 64; CL = 64; pos0 = n * 64; samp = false; }
  else { int ts = task - 1536; h = ts % 6; bidx = ts / 6; n = 0; row0 = NPR + bidx * 16; CL = 16; pos0 = 2048; samp = true; }
}

__device__ __forceinline__ void rope_load(const P& p, const u16* src  , int q4, int pos, float scale, float* o1, float* o2) {
  uint4 a = *(const uint4*)(src + q4 * 8);
  uint4 b = *(const uint4*)(src + 32 + q4 * 8);
  float x1[8], x2[8];
  x1[0] = bflo(a.x); x1[1] = bfhi(a.x); x1[2] = bflo(a.y); x1[3] = bfhi(a.y); x1[4] = bflo(a.z); x1[5] = bfhi(a.z); x1[6] = bflo(a.w); x1[7] = bfhi(a.w);
  x2[0] = bflo(b.x); x2[1] = bfhi(b.x); x2[2] = bflo(b.y); x2[3] = bfhi(b.y); x2[4] = bflo(b.z); x2[5] = bfhi(b.z); x2[6] = bflo(b.w); x2[7] = bfhi(b.w);
  const float4* rp = (const float4*)(p.rope + ((size_t)pos * 32 + q4 * 8) * 2);
#pragma unroll
  for (int e = 0; e < 4; ++e) {
    float4 cs = rp[e];
    o1[2 * e] = (x1[2 * e] * cs.x - x2[2 * e] * cs.y) * scale;
    o2[2 * e] = (x1[2 * e] * cs.y + x2[2 * e] * cs.x) * scale;
    o1[2 * e + 1] = (x1[2 * e + 1] * cs.z - x2[2 * e + 1] * cs.w) * scale;
    o2[2 * e + 1] = (x1[2 * e + 1] * cs.w + x2[2 * e + 1] * cs.z) * scale;
  }
}

__device__ __forceinline__ void ret_kv_task(const P& p, int layer, int task, unsigned char* smem) {
  const int tid = TID(), lane = tid & 63, w = tid >> 6;
  int h, row0, CL, pos0, bidx, n; bool samp;
  ret_decode(task, h, row0, CL, pos0, bidx, n, samp);
  const float lg = head_lg(h);
  u16* kT = (u16*)smem;
  u16* vT = (u16*)(smem + 9216);
  {
    const int j = tid >> 2, q4 = tid & 3;
    if (j < CL) {
      float o1[8], o2[8];
      const float dec = 0.125f * __expf((float)(CL - 1 - j) * lg);
      rope_load(p, p.proj + (size_t)(row0 + j) * DPJ + C_KC + h * 64, q4, pos0 + j, dec, o1, o2);
#pragma unroll
      for (int e = 0; e < 8; ++e) { kT[(q4 * 8 + e) * 72 + j] = f2bf(o1[e]); kT[(32 + q4 * 8 + e) * 72 + j] = f2bf(o2[e]); }
      const uint4* vs = (const uint4*)(p.proj + (size_t)(row0 + j) * DPJ + C_VC + h * 64 + q4 * 16);
      uint4 a = vs[0], b = vs[1];
      u32 ww[8] = {a.x, a.y, a.z, a.w, b.x, b.y, b.z, b.w};
#pragma unroll
      for (int e = 0; e < 8; ++e) { vT[(q4 * 16 + 2 * e) * 72 + j] = (u16)(ww[e] & 0xffff); vT[(q4 * 16 + 2 * e + 1) * 72 + j] = (u16)(ww[e] >> 16); }
    } else {
#pragma unroll
      for (int e = 0; e < 8; ++e) { kT[(q4 * 8 + e) * 72 + j] = 0; kT[(32 + q4 * 8 + e) * 72 + j] = 0; }
#pragma unroll
      for (int e = 0; e < 16; ++e) vT[(q4 * 16 + e) * 72 + j] = 0;
    }
  }
  __syncthreads();
  {
    f32x4 acc[4];
#pragma unroll
    for (int nt = 0; nt < 4; ++nt) acc[nt] = (f32x4){0.f, 0.f, 0.f, 0.f};
#pragma unroll
    for (int ks = 0; ks < 2; ++ks) {
      bf16x8 af = *(const bf16x8*)(kT + (w * 16 + (lane & 15)) * 72 + ks * 32 + (lane >> 4) * 8);
#pragma unroll
      for (int nt = 0; nt < 4; ++nt) {
        bf16x8 bfr = *(const bf16x8*)(vT + (nt * 16 + (lane & 15)) * 72 + ks * 32 + (lane >> 4) * 8);
        acc[nt] = mfma16(bfr, af, acc[nt]);
      }
    }
    const int d = w * 16 + (lane & 15);
#pragma unroll
    for (int nt = 0; nt < 4; ++nt) {
      const int e = nt * 16 + (lane >> 4) * 4;
      if (!samp) {
        *(float4*)(p.kvbuf + (((size_t)(bidx * 6 + h) * 128 + n) * 64 + d) * 64 + e) = make_float4(acc[nt][0], acc[nt][1], acc[nt][2], acc[nt][3]);
      } else {
        const size_t o = ((size_t)(layer * 32 + bidx) * 6 + h) * 4096 + d * 64 + e;
        float4 r0 = *(const float4*)(p.state_ret + o);
        const float cd = __expf(16.f * lg);
        *(float4*)(p.out + OFF_RS + o) = make_float4(cd * r0.x + acc[nt][0], cd * r0.y + acc[nt][1], cd * r0.z + acc[nt][2], cd * r0.w + acc[nt][3]);
      }
    }
  }
  __syncthreads();
}

__device__ __forceinline__ void scan_phase(const P& p, int layer, const bool dry) {
  const int tid = TID();
  for (int t = blockIdx.x; t < 192; t += gridDim.x) {
    const int bh = t >> 4, part = t & 15;
    const int h = bh % 6;
    const float cd = __expf(64.f * head_lg(h));
    float* base = p.kvbuf + (size_t)bh * 128 * 4096 + part * 256 + tid;
    float r = 0.f;
    for (int n0 = 0; n0 < 128; n0 += 32) {
      float kv[32];
#pragma unroll
      for (int i = 0; i < 32; ++i) kv[i] = base[(size_t)(n0 + i) * 4096];
#pragma unroll
      for (int i = 0; i < 32; ++i) {
        if (!dry) base[(size_t)(n0 + i) * 4096] = r;
        r = cd * r + kv[i];
      }
    }
    if (!dry || r == 1.2345e30f) p.out[OFF_RP + ((size_t)layer * 12 + bh) * 4096 + part * 256 + tid] = r;
  }
}

__device__ __forceinline__ void ret_out_task(const P& p, int layer, int task, unsigned char* smem) {
  const int tid = TID(), lane = tid & 63, w = tid >> 6;
  int h, row0, CL, pos0, bidx, n; bool samp;
  ret_decode(task, h, row0, CL, pos0, bidx, n, samp);
  const float lg = head_lg(h);
  u16* sQ = (u16*)smem; u16* sK = sQ + 4608; u16* sVT = sK + 4608; u16* sRT = sVT + 4608; u16* sS = sRT + 4608;
  {
    const int j = tid >> 2, q4 = tid & 3;
    if (j < CL) {
      float o1[8], o2[8];
      rope_load(p, p.proj + (size_t)(row0 + j) * DPJ + C_QC + h * 64, q4, pos0 + j, 1.0f, o1, o2);
      *(bf16x8*)(sQ + j * 72 + q4 * 8) = pack8(make_float4(o1[0], o1[1], o1[2], o1[3]), make_float4(o1[4], o1[5], o1[6], o1[7]));
      *(bf16x8*)(sQ + j * 72 + 32 + q4 * 8) = pack8(make_float4(o2[0], o2[1], o2[2], o2[3]), make_float4(o2[4], o2[5], o2[6], o2[7]));
      rope_load(p, p.proj + (size_t)(row0 + j) * DPJ + C_KC + h * 64, q4, pos0 + j, 0.125f, o1, o2);
      *(bf16x8*)(sK + j * 72 + q4 * 8) = pack8(make_float4(o1[0], o1[1], o1[2], o1[3]), make_float4(o1[4], o1[5], o1[6], o1[7]));
      *(bf16x8*)(sK + j * 72 + 32 + q4 * 8) = pack8(make_float4(o2[0], o2[1], o2[2], o2[3]), make_float4(o2[4], o2[5], o2[6], o2[7]));
      const uint4* vs = (const uint4*)(p.proj + (size_t)(row0 + j) * DPJ + C_VC + h * 64 + q4 * 16);
      uint4 a = vs[0], b = vs[1];
      u32 ww[8] = {a.x, a.y, a.z, a.w, b.x, b.y, b.z, b.w};
#pragma unroll
      for (int e = 0; e < 8; ++e) { sVT[(q4 * 16 + 2 * e) * 72 + j] = (u16)(ww[e] & 0xffff); sVT[(q4 * 16 + 2 * e + 1) * 72 + j] = (u16)(ww[e] >> 16); }
    } else {
      uint4 z = make_uint4(0, 0, 0, 0);
      *(uint4*)(sQ + j * 72 + q4 * 8) = z; *(uint4*)(sQ + j * 72 + 32 + q4 * 8) = z;
      *(uint4*)(sK + j * 72 + q4 * 8) = z; *(uint4*)(sK + j * 72 + 32 + q4 * 8) = z;
#pragma unroll
      for (int e = 0; e < 16; ++e) sVT[(q4 * 16 + e) * 72 + j] = 0;
    }
    const int d = tid >> 2;
    const float* rsrc = samp ? p.state_ret + ((size_t)(layer * 32 + bidx) * 6 + h) * 4096 + d * 64 + q4 * 16
                             : p.kvbuf + (((size_t)(bidx * 6 + h) * 128 + n) * 64 + d) * 64 + q4 * 16;
#pragma unroll
    for (int i = 0; i < 4; ++i) {
      float4 r = ((const float4*)rsrc)[i];
      sRT[(q4 * 16 + i * 4 + 0) * 72 + d] = f2bf(r.x); sRT[(q4 * 16 + i * 4 + 1) * 72 + d] = f2bf(r.y);
      sRT[(q4 * 16 + i * 4 + 2) * 72 + d] = f2bf(r.z); sRT[(q4 * 16 + i * 4 + 3) * 72 + d] = f2bf(r.w);
    }
  }
  __syncthreads();
  const bool active = (w * 16 < CL);
  if (active) {
    bf16x8 qf0 = *(const bf16x8*)(sQ + (w * 16 + (lane & 15)) * 72 + (lane >> 4) * 8);
    bf16x8 qf1 = *(const bf16x8*)(sQ + (w * 16 + (lane & 15)) * 72 + 32 + (lane >> 4) * 8);
    const int ia = w * 16 + (lane & 15);
    for (int jt = 0; jt < 4; ++jt) {
      uint2 pk = make_uint2(0, 0);
      if (jt <= w) {
        f32x4 acc = (f32x4){0.f, 0.f, 0.f, 0.f};
        bf16x8 kf0 = *(const bf16x8*)(sK + (jt * 16 + (lane & 15)) * 72 + (lane >> 4) * 8);
        bf16x8 kf1 = *(const bf16x8*)(sK + (jt * 16 + (lane & 15)) * 72 + 32 + (lane >> 4) * 8);
        acc = mfma16(kf0, qf0, acc); acc = mfma16(kf1, qf1, acc);
        const int ja = jt * 16 + (lane >> 4) * 4;
        float s[4];
#pragma unroll
        for (int jj = 0; jj < 4; ++jj) { int df = ia - (ja + jj); s[jj] = (df >= 0) ? acc[jj] * __expf((float)df * lg) : 0.f; }
        pk.x = pack2(s[0], s[1]); pk.y = pack2(s[2], s[3]);
      }
      *(uint2*)(sS + ia * 72 + jt * 16 + (lane >> 4) * 4) = pk;
    }
  }
  __syncthreads();
  if (active) {
    f32x4 ai[4], ac[4];
#pragma unroll
    for (int nt = 0; nt < 4; ++nt) { ai[nt] = (f32x4){0.f, 0.f, 0.f, 0.f}; ac[nt] = (f32x4){0.f, 0.f, 0.f, 0.f}; }
#pragma unroll
    for (int ks = 0; ks < 2; ++ks) {
      bf16x8 sf = *(const bf16x8*)(sS + (w * 16 + (lane & 15)) * 72 + ks * 32 + (lane >> 4) * 8);
      bf16x8 qf = *(const bf16x8*)(sQ + (w * 16 + (lane & 15)) * 72 + ks * 32 + (lane >> 4) * 8);
#pragma unroll
      for (int nt = 0; nt < 4; ++nt) {
        bf16x8 vf = *(const bf16x8*)(sVT + (nt * 16 + (lane & 15)) * 72 + ks * 32 + (lane >> 4) * 8);
        bf16x8 rf = *(const bf16x8*)(sRT + (nt * 16 + (lane & 15)) * 72 + ks * 32 + (lane >> 4) * 8);
        ai[nt] = mfma16(vf, sf, ai[nt]); ac[nt] = mfma16(rf, qf, ac[nt]);
      }
    }
    const int il = w * 16 + (lane & 15);
    const float qd = __expf((float)(il + 1) * lg);
    float y[16]; float s = 0.f;
#pragma unroll
    for (int nt = 0; nt < 4; ++nt)
#pragma unroll
      for (int jj = 0; jj < 4; ++jj) { y[nt * 4 + jj] = ai[nt][jj] + qd * ac[nt][jj]; s += y[nt * 4 + jj]; }
    s += __shfl_xor(s, 16); s += __shfl_xor(s, 32);
    const float mean = s * (1.f / 64.f);
    float q = 0.f;
#pragma unroll
    for (int i = 0; i < 16; ++i) { float dd = y[i] - mean; q += dd * dd; }
    q += __shfl_xor(q, 16); q += __shfl_xor(q, 32);
    const float rstd = rsqrtf(q * (1.f / 64.f) + 1e-5f);
    if (il < CL) {
#pragma unroll
      for (int nt = 0; nt < 4; ++nt) {
        const int e = nt * 16 + (lane >> 4) * 4;
        float4 gg = *(const float4*)(p.c_gn_g + layer * 384 + h * 64 + e);
        uint2 gr = *(const uint2*)(p.proj + (size_t)(row0 + il) * DPJ + C_GC + h * 64 + e);
        uint2 o;
        o.x = pack2(silu_f(bflo(gr.x)) * (y[nt * 4 + 0] - mean) * rstd * gg.x, silu_f(bfhi(gr.x)) * (y[nt * 4 + 1] - mean) * rstd * gg.y);
        o.y = pack2(silu_f(bflo(gr.y)) * (y[nt * 4 + 2] - mean) * rstd * gg.z, silu_f(bfhi(gr.y)) * (y[nt * 4 + 3] - mean) * rstd * gg.w);
        *(uint2*)(p.mix + (size_t)(row0 + il) * DM + 640 + h * 64 + e) = o;
      }
    }
  }
  __syncthreads();
}

constexpr int DS_SEL = 32768, DS_CS = 36864, DS_CI = 40960, DS_STAT = 43008, DS_THR = 43072, DS_CNT = 43136, DS_NV = 43200;
constexpr int CANDC = 128;

template <bool SAMPLE> __forceinline__
__device__ __forceinline__ void dsa_task(const P& p, int layer, int qrow0, int kb_row0, int sb, int L, unsigned char* smem) {
  const int tid = TID(), lane = tid & 63, w = tid >> 6;
  u32* hist = (u32*)smem;
  u16* sel = (u16*)(smem + DS_SEL);
  float* cand_s = (float*)(smem + DS_CS);
  u16* cand_i = (u16*)(smem + DS_CI);
  float* stats = (float*)(smem + DS_STAT);
  int* thr = (int*)(smem + DS_THR);
  u32* cnt = (u32*)(smem + DS_CNT);
  int* nval = (int*)(smem + DS_NV);

  auto ki_frag = [&](int key, int koff) -> bf16x8 {
    if (SAMPLE) {
      if (key < 2048) {
        const float* f = p.cache_ki + (((size_t)layer * 32 + sb) * 2048 + key) * 32 + koff;
        return pack8(((const float4*)f)[0], ((const float4*)f)[1]);
      }
      return *(const bf16x8*)(p.kic + (size_t)(kb_row0 + key - 2048) * 32 + koff);
    }
    return *(const bf16x8*)(p.kic + (size_t)(kb_row0 + key) * 32 + koff);
  };

  if (L <= 256) {
    for (int i = tid; i < 8 * 256; i += 256) sel[i] = (u16)(i & 255);
    if (tid < 8) nval[tid] = L;
    __syncthreads();
  } else {
    bf16x8 qa[2][2], a2[2][2];
    {
      const int r = lane & 31; const int hh = (r >> 2) & 1; const int i = (r >> 3) * 4 + (r & 3);
      const int qit = 2 * hh + (i >> 3), head = i & 7;
#pragma unroll
      for (int T = 0; T < 2; ++T)
#pragma unroll
        for (int ks = 0; ks < 2; ++ks)
          qa[T][ks] = *(const bf16x8*)(p.proj + (size_t)(qrow0 + 4 * T + qit) * DPJ + C_QI + head * 32 + ks * 16 + (lane >> 5) * 8);
      const int kh = lane >> 5;
#pragma unroll
      for (int T = 0; T < 2; ++T)
#pragma unroll
        for (int ks = 0; ks < 2; ++ks) {
          bf16x8 v = (bf16x8){0, 0, 0, 0, 0, 0, 0, 0};
          if (r == (2 * T + ks) * 8 + 4 * kh) v = *(const bf16x8*)(p.proj + (size_t)(qrow0 + 4 * T + 2 * kh + ks) * DPJ + C_WI);
          a2[T][ks] = v;
        }
    }
#define LOADK(T_, K0, K1) { int key_ = (T_) * 32 + (lane & 31); int kc_ = key_ < L ? key_ : L - 1; K0 = ki_frag(kc_, (lane >> 5) * 8); K1 = ki_frag(kc_, 16 + (lane >> 5) * 8); }
    auto score_k = [&](bf16x8 kf0, bf16x8 kf1, float* sc) {
      __builtin_amdgcn_s_setprio(1);
      f32x16 x0, x1, s0, s1;
#pragma unroll
      for (int i = 0; i < 16; ++i) { x0[i] = 0.f; x1[i] = 0.f; s0[i] = 0.f; s1[i] = 0.f; }
      x0 = mfma32(qa[0][0], kf0, x0); x1 = mfma32(qa[1][0], kf0, x1);
      x0 = mfma32(qa[0][1], kf1, x0); x1 = mfma32(qa[1][1], kf1, x1);
      uint4 b00, b01, b10, b11;
      b00.x = pack2_relu(x0[0], x0[1]);  b00.y = pack2_relu(x0[2], x0[3]);   b00.z = pack2_relu(x0[4], x0[5]);   b00.w = pack2_relu(x0[6], x0[7]);
      b01.x = pack2_relu(x0[8], x0[9]);  b01.y = pack2_relu(x0[10], x0[11]); b01.z = pack2_relu(x0[12], x0[13]); b01.w = pack2_relu(x0[14], x0[15]);
      b10.x = pack2_relu(x1[0], x1[1]);  b10.y = pack2_relu(x1[2], x1[3]);   b10.z = pack2_relu(x1[4], x1[5]);   b10.w = pack2_relu(x1[6], x1[7]);
      b11.x = pack2_relu(x1[8], x1[9]);  b11.y = pack2_relu(x1[10], x1[11]); b11.z = pack2_relu(x1[12], x1[13]); b11.w = pack2_relu(x1[14], x1[15]);
      s0 = mfma32(a2[0][0], __builtin_bit_cast(bf16x8, b00), s0); s1 = mfma32(a2[1][0], __builtin_bit_cast(bf16x8, b10), s1);
      s0 = mfma32(a2[0][1], __builtin_bit_cast(bf16x8, b01), s0); s1 = mfma32(a2[1][1], __builtin_bit_cast(bf16x8, b11), s1);
      sc[0] = s0[0]; sc[1] = s0[4]; sc[2] = s1[8]; sc[3] = s1[12];
      __builtin_amdgcn_s_setprio(0);
    };
    const int qbase = 2 * (lane >> 5);
    for (int i = tid; i < 8192 / 4; i += 256) ((uint4*)hist)[i] = make_uint4(0, 0, 0, 0);
    if (tid < 16) stats[tid] = 0.f;
    if (tid < 16) cnt[tid] = 0;
    __syncthreads();
    {
      float sm[4] = {0.f, 0.f, 0.f, 0.f}, sq[4] = {0.f, 0.f, 0.f, 0.f};
      bf16x8 a0, a1, b0, b1;
      LOADK(w, a0, a1); LOADK(w + 4, b0, b1);
      { float sc[4]; score_k(a0, a1, sc);
#pragma unroll
        for (int x = 0; x < 4; ++x) { sm[x] += sc[x]; sq[x] += sc[x] * sc[x]; } }
      { float sc[4]; score_k(b0, b1, sc);
#pragma unroll
        for (int x = 0; x < 4; ++x) { sm[x] += sc[x]; sq[x] += sc[x] * sc[x]; } }
#pragma unroll
      for (int x = 0; x < 4; ++x) {
#pragma unroll
        for (int o = 1; o < 32; o <<= 1) { sm[x] += __shfl_xor(sm[x], o); sq[x] += __shfl_xor(sq[x], o); }
      }
      if ((lane & 31) == 0) {
#pragma unroll
        for (int x = 0; x < 4; ++x) { int q = 4 * (x >> 1) + qbase + (x & 1); atomicAdd(&stats[q * 2], sm[x]); atomicAdd(&stats[q * 2 + 1], sq[x]); }
      }
    }
    __syncthreads();
    float mu[4], inv[4];
#pragma unroll
    for (int x = 0; x < 4; ++x) {
      int q = 4 * (x >> 1) + qbase + (x & 1);
      float m = stats[q * 2] * (1.f / 256.f);
      float var = stats[q * 2 + 1] * (1.f / 256.f) - m * m;
      mu[x] = m; inv[x] = 128.f * rsqrtf(fmaxf(var, 1e-20f));
    }
    const int ntiles = (L + 31) >> 5;
#define CLAMPT(T_) ((T_) < ntiles ? (T_) : ntiles - 1)
    {
      auto body1 = [&](bf16x8 k0, bf16x8 k1, int t) {
        float sc[4]; score_k(k0, k1, sc);
        if (t * 32 + (lane & 31) < L) {
#pragma unroll
          for (int x = 0; x < 4; ++x) {
            int q = 4 * (x >> 1) + qbase + (x & 1);
            int bin = (int)((sc[x] - mu[x]) * inv[x]) + 512; bin = bin < 0 ? 0 : (bin > 1023 ? 1023 : bin);
            atomicAdd(&hist[q * 1024 + bin], 1u);
          }
        }
      };
      bf16x8 a0, a1, b0, b1, c0, c1, d0, d1;
      LOADK(CLAMPT(w), a0, a1); LOADK(CLAMPT(w + 4), b0, b1); LOADK(CLAMPT(w + 8), c0, c1);
      for (int t = w; t < ntiles; t += 16) {
        LOADK(CLAMPT(t + 12), d0, d1); body1(a0, a1, t);
        if (t + 4 < ntiles) { LOADK(CLAMPT(t + 16), a0, a1); body1(b0, b1, t + 4); }
        if (t + 8 < ntiles) { LOADK(CLAMPT(t + 20), b0, b1); body1(c0, c1, t + 8); }
        if (t + 12 < ntiles) { LOADK(CLAMPT(t + 24), c0, c1); body1(d0, d1, t + 12); }
      }
    }
    __syncthreads();
    for (int qq = 0; qq < 2; ++qq) {
      const int q = 2 * w + qq;
      const uint4* hp = (const uint4*)(hist + q * 1024 + lane * 16);
      uint4 h0 = hp[0], h1 = hp[1], h2 = hp[2], h3 = hp[3];
      u32 hv[16] = {h0.x, h0.y, h0.z, h0.w, h1.x, h1.y, h1.z, h1.w, h2.x, h2.y, h2.z, h2.w, h3.x, h3.y, h3.z, h3.w};
      u32 tot = 0;
#pragma unroll
      for (int i = 0; i < 16; ++i) tot += hv[i];
      u32 incl = tot;
#pragma unroll
      for (int o = 1; o < 64; o <<= 1) { u32 v = __shfl_down(incl, o); if (lane + o < 64) incl += v; }
      unsigned long long bal = __ballot(incl >= 256u);
      const int Ls = 63 - __clzll(bal);
      if (lane == Ls) {
        u32 cum = incl - tot; int bstar = lane * 16; u32 nab = cum; bool found = false;
#pragma unroll
        for (int b = 15; b >= 0; --b) {
          if (!found) { if (cum + hv[b] >= 256u) { bstar = lane * 16 + b; nab = cum; found = true; } else cum += hv[b]; }
        }
        thr[q * 2] = bstar; thr[q * 2 + 1] = (int)nab;
      }
    }
    __syncthreads();
    int bst[4];
#pragma unroll
    for (int x = 0; x < 4; ++x) { int q = 4 * (x >> 1) + qbase + (x & 1); bst[x] = thr[q * 2]; }
    {
      auto body2 = [&](bf16x8 k0, bf16x8 k1, int t) {
        float sc[4]; score_k(k0, k1, sc);
        const int key = t * 32 + (lane & 31);
        if (key < L) {
#pragma unroll
          for (int x = 0; x < 4; ++x) {
            int q = 4 * (x >> 1) + qbase + (x & 1);
            int bin = (int)((sc[x] - mu[x]) * inv[x]) + 512; bin = bin < 0 ? 0 : (bin > 1023 ? 1023 : bin);
            if (bin > bst[x]) { u32 s_ = atomicAdd(&cnt[q * 2], 1u); if (s_ < 256u) sel[q * 256 + s_] = (u16)key; }
            else if (bin == bst[x]) { u32 s_ = atomicAdd(&cnt[q * 2 + 1], 1u); if (s_ < (u32)CANDC) { cand_s[q * CANDC + s_] = sc[x]; cand_i[q * CANDC + s_] = (u16)key; } }
          }
        }
      };
      bf16x8 a0, a1, b0, b1, c0, c1, d0, d1;
      LOADK(CLAMPT(w), a0, a1); LOADK(CLAMPT(w + 4), b0, b1); LOADK(CLAMPT(w + 8), c0, c1);
      for (int t = w; t < ntiles; t += 16) {
        LOADK(CLAMPT(t + 12), d0, d1); body2(a0, a1, t);
        if (t + 4 < ntiles) { LOADK(CLAMPT(t + 16), a0, a1); body2(b0, b1, t + 4); }
        if (t + 8 < ntiles) { LOADK(CLAMPT(t + 20), b0, b1); body2(c0, c1, t + 8); }
        if (t + 12 < ntiles) { LOADK(CLAMPT(t + 24), c0, c1); body2(d0, d1, t + 12); }
      }
    }
#undef CLAMPT
#undef LOADK
    __syncthreads();
    for (int qq = 0; qq < 2; ++qq) {
      const int q = 2 * w + qq;
      int m = (int)cnt[q * 2 + 1]; m = m > CANDC ? CANDC : m;
      const int nab = thr[q * 2 + 1];
      const int r = 256 - nab;
      for (int a = lane; a < m; a += 64) {
        const float sa = cand_s[q * CANDC + a]; const int ia = cand_i[q * CANDC + a];
        int rank = 0;
        for (int b = 0; b < m; ++b) {
          const float sbv = cand_s[q * CANDC + b]; const int ib = cand_i[q * CANDC + b];
          rank += ((sbv > sa) || (sbv == sa && ib < ia)) ? 1 : 0;
        }
        if (rank < r) sel[q * 256 + nab + rank] = (u16)ia;
      }
      if (lane == 0) nval[q] = nab + (r < m ? r : m);
    }
    __syncthreads();
  }

  float* Pbuf = (float*)smem + w * 2048;
  for (int qq = 0; qq < 2; ++qq) {
    const int q = 2 * w + qq;
    const int qrow = qrow0 + q;
    const int nv = nval[q];
    if (!SAMPLE) {
      typedef __attribute__((address_space(3))) unsigned lds_u32;
      typedef unsigned u32x2 __attribute__((ext_vector_type(2)));
      const int head = lane & 15;
      bf16x8 qf0, qf1;
      if (head < 6) {
        qf0 = *(const bf16x8*)(p.proj + (size_t)qrow * DPJ + C_QB + head * 64 + (lane >> 4) * 8);
        qf1 = *(const bf16x8*)(p.proj + (size_t)qrow * DPJ + C_QB + head * 64 + 32 + (lane >> 4) * 8);
      } else {
        qf0 = (bf16x8){0, 0, 0, 0, 0, 0, 0, 0}; qf1 = qf0;
      }
      f32x4 lgt[16];
#pragma unroll
      for (int kt = 0; kt < 16; ++kt) {
        const int slot = kt * 16 + (lane & 15);
        const int idx = slot < nv ? (int)sel[q * 256 + slot] : 0;
        const u16* kp = p.kc + (size_t)(kb_row0 + idx) * 64 + (lane >> 4) * 8;
        bf16x8 kf0 = *(const bf16x8*)kp, kf1 = *(const bf16x8*)(kp + 32);
        f32x4 acc = (f32x4){0.f, 0.f, 0.f, 0.f};
        acc = mfma16(kf0, qf0, acc); acc = mfma16(kf1, qf1, acc);
#pragma unroll
        for (int jj = 0; jj < 4; ++jj) lgt[kt][jj] = (kt * 16 + (lane >> 4) * 4 + jj) < nv ? acc[jj] * 0.125f : -INFINITY;
        if ((kt & 7) == 7) __builtin_amdgcn_sched_barrier(0);
      }
      float mx = -INFINITY;
#pragma unroll
      for (int kt = 0; kt < 16; ++kt)
#pragma unroll
        for (int jj = 0; jj < 4; ++jj) mx = fmaxf(mx, lgt[kt][jj]);
      mx = fmaxf(mx, __shfl_xor(mx, 16)); mx = fmaxf(mx, __shfl_xor(mx, 32));
      float sm = 0.f;
#pragma unroll
      for (int kt = 0; kt < 16; ++kt)
#pragma unroll
        for (int jj = 0; jj < 4; ++jj) { float e = __expf(lgt[kt][jj] - mx); lgt[kt][jj] = e; sm += e; }
      sm += __shfl_xor(sm, 16); sm += __shfl_xor(sm, 32);
      const float inv = 1.f / sm;
      unsigned char* Pw = smem + w * 3200;
      unsigned char* Vb0 = smem + 12800 + w * 4096;
      unsigned char* Vb1 = smem + 43264 + w * 4096;
      asm volatile("s_waitcnt vmcnt(0) lgkmcnt(0)" ::: "memory");
      if (head < 6) {
#pragma unroll
        for (int kt = 0; kt < 16; ++kt) {
          uint2 pk; pk.x = pack2(lgt[kt][0] * inv, lgt[kt][1] * inv); pk.y = pack2(lgt[kt][2] * inv, lgt[kt][3] * inv);
          *(uint2*)(Pw + head * 528 + (kt * 16 + (lane >> 4) * 4) * 2) = pk;
        }
      }
      const int drow = lane >> 3;
      const int dch0 = (((lane & 7) ^ (((lane >> 4) & 1) * 2)) << 3);
      const int dch1 = (((lane & 7) ^ (((lane >> 4) & 1) * 2 + 4)) << 3);
      bf16x8 af[8];
      int vidx[8][4];
#pragma unroll
      for (int ks = 0; ks < 8; ++ks) {
        af[ks] = (bf16x8){0, 0, 0, 0, 0, 0, 0, 0};
        if (head < 6) af[ks] = *(const bf16x8*)(Pw + head * 528 + (ks * 32 + (lane >> 4) * 8) * 2);
#pragma unroll
        for (int i = 0; i < 4; ++i) { const int slot_ = ks * 32 + i * 8 + drow; vidx[ks][i] = slot_ < nv ? (int)sel[q * 256 + slot_] : 0; }
      }
      asm volatile("s_waitcnt lgkmcnt(0)" ::: "memory");
#define PV_DMA(KS, BUF) { _Pragma("unroll") for (int i = 0; i < 4; ++i) { \
          __builtin_amdgcn_global_load_lds((const unsigned*)(p.vc + (size_t)(kb_row0 + vidx[KS][i]) * 64 + ((i & 1) ? dch1 : dch0)), (lds_u32*)((BUF) + i * 1024 + lane * 16), 16, 0, 0); } }
      const int tg = lane >> 4, tq = (lane & 15) >> 2, tp = lane & 3;
      const int trow = 8 * tg + tq, tf = ((tq >> 1) & 1) * 2 + (tg & 1) * 4;
      unsigned tad[4];
#pragma unroll
      for (int nt = 0; nt < 4; ++nt) tad[nt] = (unsigned)(trow * 128 + (((2 * nt + (tp >> 1)) ^ tf) << 4) + 8 * (tp & 1));
      const unsigned vb0a = (unsigned)(size_t)((__attribute__((address_space(3))) unsigned char*)Vb0);
      const unsigned vb1a = (unsigned)(size_t)((__attribute__((address_space(3))) unsigned char*)Vb1);
      f32x4 o[4];
#pragma unroll
      for (int nt = 0; nt < 4; ++nt) o[nt] = (f32x4){0.f, 0.f, 0.f, 0.f};
#define PV_STEP(KS, VBA) { u32x2 lo[4], hi[4]; \
        _Pragma("unroll") for (int nt = 0; nt < 4; ++nt) { \
          asm volatile("ds_read_b64_tr_b16 %0, %1" : "=v"(lo[nt]) : "v"((VBA) + tad[nt])); \
          asm volatile("ds_read_b64_tr_b16 %0, %1 offset:512" : "=v"(hi[nt]) : "v"((VBA) + tad[nt])); } \
        asm volatile("s_waitcnt lgkmcnt(0)" : "+v"(lo[0]), "+v"(lo[1]), "+v"(lo[2]), "+v"(lo[3]), "+v"(hi[0]), "+v"(hi[1]), "+v"(hi[2]), "+v"(hi[3]) :: "memory"); \
        _Pragma("unroll") for (int nt = 0; nt < 4; ++nt) { uint4 b4; b4.x = lo[nt].x; b4.y = lo[nt].y; b4.z = hi[nt].x; b4.w = hi[nt].y; \
          o[nt] = mfma16(af[KS], __builtin_bit_cast(bf16x8, b4), o[nt]); } }
      const int nks = (nv + 31) >> 5;
      PV_DMA(0, Vb0);
#pragma unroll
      for (int ks = 0; ks < 8; ks += 2) {
        if (ks < nks) {
          PV_DMA(ks + 1, Vb1);
          asm volatile("s_waitcnt vmcnt(4)" ::: "memory");
          PV_STEP(ks, vb0a);
          if (ks + 2 < nks) {
            if (ks + 2 < 8) PV_DMA((ks + 2 < 8 ? ks + 2 : 0), Vb0);
            asm volatile("s_waitcnt vmcnt(4)" ::: "memory");
          } else asm volatile("s_waitcnt vmcnt(0)" ::: "memory");
          PV_STEP(ks + 1, vb1a);
        }
      }
#undef PV_DMA
#undef PV_STEP
      if (lane < 32) {
#pragma unroll
        for (int nt = 0; nt < 4; ++nt)
#pragma unroll
          for (int jj = 0; jj < 4; ++jj) {
            const int hd = (lane >> 4) * 4 + jj;
            if (hd < 6) p.mix[(size_t)qrow * DM + 256 + hd * 64 + nt * 16 + (lane & 15)] = f2bf(o[nt][jj]);
          }
      }
    } else {
    const int head = lane & 15;
    bf16x8 qf0, qf1;
    if (head < 6) {
      qf0 = *(const bf16x8*)(p.proj + (size_t)qrow * DPJ + C_QB + head * 64 + (lane >> 4) * 8);
      qf1 = *(const bf16x8*)(p.proj + (size_t)qrow * DPJ + C_QB + head * 64 + 32 + (lane >> 4) * 8);
    } else {
      qf0 = (bf16x8){0, 0, 0, 0, 0, 0, 0, 0}; qf1 = qf0;
    }
    f32x4 lgt[16];
#pragma unroll
    for (int kt = 0; kt < 16; ++kt) {
      const int slot = kt * 16 + (lane & 15);
      const int idx = slot < nv ? (int)sel[q * 256 + slot] : 0;
      bf16x8 kf0, kf1;
      if (SAMPLE) {
        if (idx < 2048) {
          const float* f = p.cache_k + (((size_t)layer * 32 + sb) * 2048 + idx) * 64 + (lane >> 4) * 8;
          kf0 = pack8(((const float4*)f)[0], ((const float4*)f)[1]);
          kf1 = pack8(((const float4*)(f + 32))[0], ((const float4*)(f + 32))[1]);
        } else {
          const u16* kp = p.kc + (size_t)(kb_row0 + idx - 2048) * 64 + (lane >> 4) * 8;
          kf0 = *(const bf16x8*)kp; kf1 = *(const bf16x8*)(kp + 32);
        }
      } else {
        const u16* kp = p.kc + (size_t)(kb_row0 + idx) * 64 + (lane >> 4) * 8;
        kf0 = *(const bf16x8*)kp; kf1 = *(const bf16x8*)(kp + 32);
      }
      f32x4 acc = (f32x4){0.f, 0.f, 0.f, 0.f};
      acc = mfma16(qf0, kf0, acc); acc = mfma16(qf1, kf1, acc);
      const bool ok = slot < nv;
#pragma unroll
      for (int jj = 0; jj < 4; ++jj) lgt[kt][jj] = ok ? acc[jj] * 0.125f : -INFINITY;
      if ((kt & 7) == 7) __builtin_amdgcn_sched_barrier(0);
    }
    float inv_[4], mx_[4];
#pragma unroll
    for (int jj = 0; jj < 4; ++jj) {
      float mx = -INFINITY;
#pragma unroll
      for (int kt = 0; kt < 16; ++kt) mx = fmaxf(mx, lgt[kt][jj]);
#pragma unroll
      for (int o = 1; o < 16; o <<= 1) mx = fmaxf(mx, __shfl_xor(mx, o));
      float sm = 0.f;
#pragma unroll
      for (int kt = 0; kt < 16; ++kt) { float e = __expf(lgt[kt][jj] - mx); lgt[kt][jj] = e; sm += e; }
#pragma unroll
      for (int o = 1; o < 16; o <<= 1) sm += __shfl_xor(sm, o);
      inv_[jj] = 1.f / sm; mx_[jj] = mx;
    }
    asm volatile("s_waitcnt lgkmcnt(0)" ::: "memory");
    __builtin_amdgcn_wave_barrier();
    if (lane < 32) {
      const int hb = (lane >> 4) * 4;
#pragma unroll
      for (int kt = 0; kt < 16; ++kt) {
        const int slot = kt * 16 + (lane & 15);
        if (hb == 0) {
          *(float4*)(Pbuf + slot * 8) = make_float4(lgt[kt][0] * inv_[0], lgt[kt][1] * inv_[1], lgt[kt][2] * inv_[2], lgt[kt][3] * inv_[3]);
        } else {
          *(float2*)(Pbuf + slot * 8 + 4) = make_float2(lgt[kt][0] * inv_[0], lgt[kt][1] * inv_[1]);
        }
      }
    }
    asm volatile("s_waitcnt lgkmcnt(0)" ::: "memory");
    __builtin_amdgcn_wave_barrier();
    {
      typedef float f2v __attribute__((ext_vector_type(2)));
      const int sg = lane >> 3, dc = lane & 7;
      f2v o[6][4];
#pragma unroll
      for (int hh = 0; hh < 6; ++hh)
#pragma unroll
        for (int j = 0; j < 4; ++j) o[hh][j] = (f2v){0.f, 0.f};
      const int nit = (nv + 7) >> 3;
#pragma unroll 8
      for (int it = 0; it < nit; ++it) {
        const int slot = it * 8 + sg;
        const int idx = slot < nv ? (int)sel[q * 256 + slot] : 0;
        f2v vv[4];
        if (SAMPLE) {
          if (idx < 2048) {
            const float* vp = p.cache_v + (((size_t)layer * 32 + sb) * 2048 + idx) * 64 + dc * 8;
            float4 x0 = ((const float4*)vp)[0], x1 = ((const float4*)vp)[1];
            vv[0] = (f2v){x0.x, x0.y}; vv[1] = (f2v){x0.z, x0.w}; vv[2] = (f2v){x1.x, x1.y}; vv[3] = (f2v){x1.z, x1.w};
          } else {
            uint4 x = *(const uint4*)(p.vc + (size_t)(kb_row0 + idx - 2048) * 64 + dc * 8);
            vv[0] = (f2v){bflo(x.x), bfhi(x.x)}; vv[1] = (f2v){bflo(x.y), bfhi(x.y)}; vv[2] = (f2v){bflo(x.z), bfhi(x.z)}; vv[3] = (f2v){bflo(x.w), bfhi(x.w)};
          }
        } else {
          uint4 x = *(const uint4*)(p.vc + (size_t)(kb_row0 + idx) * 64 + dc * 8);
          vv[0] = (f2v){bflo(x.x), bfhi(x.x)}; vv[1] = (f2v){bflo(x.y), bfhi(x.y)}; vv[2] = (f2v){bflo(x.z), bfhi(x.z)}; vv[3] = (f2v){bflo(x.w), bfhi(x.w)};
        }
        float4 pa = *(const float4*)(Pbuf + slot * 8);
        float2 pb = *(const float2*)(Pbuf + slot * 8 + 4);
        const float ph_[6] = {pa.x, pa.y, pa.z, pa.w, pb.x, pb.y};
#pragma unroll
        for (int hh = 0; hh < 6; ++hh) {
          const f2v pp = (f2v){ph_[hh], ph_[hh]};
#pragma unroll
          for (int j = 0; j < 4; ++j) o[hh][j] = pp * vv[j] + o[hh][j];
        }
      }
#pragma unroll
      for (int hh = 0; hh < 6; ++hh) {
#pragma unroll
        for (int j = 0; j < 4; ++j) {
#pragma unroll
          for (int m = 8; m < 64; m <<= 1) { o[hh][j].x += __shfl_xor(o[hh][j].x, m); o[hh][j].y += __shfl_xor(o[hh][j].y, m); }
        }
        if (lane < 8) {
          uint4 r4; r4.x = pack2(o[hh][0].x, o[hh][0].y); r4.y = pack2(o[hh][1].x, o[hh][1].y); r4.z = pack2(o[hh][2].x, o[hh][2].y); r4.w = pack2(o[hh][3].x, o[hh][3].y);
          *(uint4*)(p.mix + (size_t)qrow * DM + 256 + hh * 64 + dc * 8) = r4;
        }
      }
    }
    }
  }
  __syncthreads();
}

constexpr int NT_KV = 1536 + 192, NT_MA = 512 + 128, NT_DS = 64, NT_DP = 2048;

#define WQ_BASE 3520
#define WQ_WORDS 3712
__device__ __forceinline__ int wq_next(unsigned* ctr, int* s_task) {
  __syncthreads();
  if (threadIdx.x == 0) *s_task = (int)atomicAdd(ctr, 1u);
  __syncthreads();
  return *s_task;
}
#define WQ_LOOP(CTR, N, VAR, ...) { int VAR = wq_next(CTR, s_task); while (VAR < (N)) { \
    if (threadIdx.x == 0) s_task[1] = (int)atomicAdd(CTR, 1u); \
    __VA_ARGS__; \
    VAR = s_task[1]; __syncthreads(); } }
__device__ __forceinline__ void mix1_phase(const P& p, int layer, unsigned char* smem, const int sub, int* s_task) {
  unsigned* ctr = p.bar + WQ_BASE + layer * 64;
  if (sub & 4) WQ_LOOP(ctr, NT_DS, s, { int sb = s >> 1, sb2 = s & 1;
    dsa_task<true>(p, layer, NPR + sb * 16 + sb2 * 8, NPR + sb * 16, sb, 2064, smem); })
  if (sub & 8) WQ_LOOP(ctr + 16, NT_DP, d, { int c = 127 - (d >> 4); int bb = (d >> 3) & 1; int sb2 = d & 7;
    dsa_task<false>(p, layer, bb * 8192 + c * 64 + sb2 * 8, bb * 8192, 0, (c + 1) * 64, smem); })
  if (sub & 2) WQ_LOOP(ctr + 32, NT_MA, t, { mixer_a_task(p, layer, t, smem); })
  if (sub & 1) WQ_LOOP(ctr + 48, NT_KV, t, { ret_kv_task(p, layer, t, smem); })
}
#undef WQ_LOOP

constexpr int NPHASE = 1 + 2 * 13;

__device__ __forceinline__ void run_phase(const P& p, int ph, unsigned char* smem, const bool dry, int* s_task) {
  if (ph == 0) { prep_phase(p, smem); return; }
  const int layer = (ph - 1) / 13, k = (ph - 1) % 13;
  if (k == 0 || k == 4 || k == 6 || k == 9 || k == 8 || k == 10 || k == 11) {
    int epi, NTN, mtiles, mt_base = 0, slab = -1, lda, K; const u16 *A, *Bt;
    if (k == 0) { epi = EPI_IN; NTN = DPJP / 128; mtiles = NR / 128; A = p.xb; lda = DM; K = DM; Bt = p.WinT + (size_t)layer * DPJP * DM; }
    else if (k == 4) { epi = EPI_OUT; NTN = 8; mtiles = NR / 128; A = p.mix; lda = DM; K = DM; Bt = p.WoutT + (size_t)layer * DM * DM; }
    else if (k == 6 || k == 9) { epi = EPI_GU; NTN = 44; slab = (k == 6) ? 0 : 1; mtiles = (k == 6) ? 68 : 64; A = p.xb; lda = DM; K = DM; Bt = p.WguT + (size_t)layer * 2 * DFF * DM; }
    else { epi = EPI_DOWN; NTN = 8; slab = (k == 11) ? 1 : 0; mtiles = (k == 10) ? 4 : 64; mt_base = (k == 10) ? 64 : 0; A = p.hu; lda = DFF; K = DFF; Bt = p.WdT + (size_t)layer * DM * DFF; }
    const int xcd = blockIdx.x & 7, jloc = blockIdx.x >> 3, nloc = gridDim.x >> 3;
    const int T = mtiles * NTN;
    const int u0 = (int)(((long)T * xcd) >> 3), u1 = (int)(((long)T * (xcd + 1)) >> 3);
    for (int u = u0 + jloc; u < u1; u += nloc) {
      const int sr = u / (8 * NTN);
      const int v = u - sr * 8 * NTN;
      const int Mr = (mtiles - sr * 8) < 8 ? (mtiles - sr * 8) : 8;
      const int nt = v / Mr, mi = v - nt * Mr;
      const int mtl = mt_base + sr * 8 + mi;
      const int hrow0 = mtl * 128;
      const int grow0 = (slab == 0) ? (mtl < 64 ? hrow0 : NPR + (mtl - 64) * 128) : (slab == 1 ? 8192 + hrow0 : hrow0);
      const u16* At = (epi == EPI_DOWN) ? A + (size_t)hrow0 * lda : A + (size_t)grow0 * lda;
      gemm_tile(p, epi, layer, grow0 - hrow0, At, lda, Bt + (size_t)nt * 128 * K, K, K, grow0, nt * 128, smem, dry);
    }
    if (k == 10) act_phase(p, layer, 1, 8192, dry, 32);
    return;
  }
  switch (k) {
    case 1: mix1_phase(p, layer, smem, 15, s_task); break;
    case 2: scan_phase(p, layer, dry);
      if (!dry && gridDim.x > 192) for (int t = 1536 + ((int)blockIdx.x - 192); t >= 1536 && t < NT_KV; t += gridDim.x - 192) ret_out_task(p, layer, t, smem);
      break;
    case 3: for (int t = blockIdx.x; t < (gridDim.x > 192 ? 1536 : NT_KV); t += gridDim.x) ret_out_task(p, layer, t, smem); break;
    case 5: ln_phase(p, p.ln1_g + layer * DM, p.ln1_b + layer * DM, dry, false, true, p.zb1); break;
    case 7: act_phase(p, layer, 0, 8704, dry, 0); break;
    case 12: ln_phase(p, p.ln2_g + layer * DM, p.ln2_b + layer * DM, dry, layer == 1, layer == 0, p.zb2); break;
  }
}

__global__ void __launch_bounds__(256, 2) mega(P p, int ph0, int ph1, int dryflag) {
  __shared__ __attribute__((aligned(16))) unsigned char smem[73728];
  __shared__ uint4 xb_words;
  __shared__ int s_task[2];
  if (threadIdx.x == 0) xb_words = make_uint4(0u, 0u, 0u, 0u);
  __syncthreads();
  XcdBarrier xb = xcd_barrier_post(p.bar, (volatile LAS unsigned*)&xb_words);
  if (ph1 < 0) cg::this_grid().sync();
  for (int ph = ph0; ph < ph1; ++ph) {
    run_phase(p, ph, smem, false, s_task);
#if PROBE_MASK
    if (ph > 0 && ((PROBE_MASK >> ((ph - 1) % 13)) & 1)) run_phase(p, ph, smem, dryflag != 0, s_task);
    if (ph > 0 && ((ph - 1) % 13) == 1 && (PROBE_MASK >> 13)) mix1_phase(p, (ph - 1) / 13, smem, (PROBE_MASK >> 13) & (14 + dryflag), s_task);
#endif
    if (ph + 1 < ph1) xcd_barrier(xb);
  }
}

extern "C" void kernel_launch(void* const* d_in, const int* in_sizes, int n_in, void* d_out, int out_size, void* d_ws,
                              size_t ws_size, hipStream_t stream) {
  P p{};
  p.x_prompt = (const float*)d_in[0]; p.x_sample = (const float*)d_in[1]; p.cache_k = (const float*)d_in[2];
  p.cache_v = (const float*)d_in[3]; p.cache_ki = (const float*)d_in[4]; p.state_ret = (const float*)d_in[5];
  p.state_conv = (const float*)d_in[6]; p.w_in = (const float*)d_in[7]; p.a_ln_g = (const float*)d_in[8];
  p.a_ln_b = (const float*)d_in[9]; p.a_ws = (const float*)d_in[10]; p.a_bs = (const float*)d_in[11];
  p.c_gn_g = (const float*)d_in[12]; p.w_out = (const float*)d_in[13]; p.ln1_g = (const float*)d_in[14];
  p.ln1_b = (const float*)d_in[15]; p.w_gate = (const float*)d_in[16]; p.w_up = (const float*)d_in[17];
  p.conv_w = (const float*)d_in[18]; p.conv_b = (const float*)d_in[19]; p.w_down = (const float*)d_in[20];
  p.ln2_g = (const float*)d_in[21]; p.ln2_b = (const float*)d_in[22];
  p.out = (float*)d_out;
  unsigned char* ws = (unsigned char*)d_ws;
  size_t o = 0;
  p.WinT = (u16*)(ws + o);  o += 2ull * DPJP * DM * 2;
  p.WoutT = (u16*)(ws + o); o += 2ull * DM * DM * 2;
  p.WguT = (u16*)(ws + o);  o += 2ull * 2 * DFF * DM * 2;
  p.WdT = (u16*)(ws + o);   o += 2ull * DM * DFF * 2;
  p.rope = (float*)(ws + o); o += 8192ull * 32 * 2 * 4;
  p.xb = (u16*)(ws + o);    o += (size_t)NR * DM * 2;
  unsigned char* big = ws + o;
  p.proj = (u16*)big;
  p.mix = (u16*)(big + (size_t)NR * DPJ * 2);
  p.kvbuf = (float*)(big + (size_t)NR * DPJ * 2 + (size_t)NR * DM * 2);
  p.hg = (u16*)big;
  p.hu = (u16*)(big + 8704ull * DFF * 2);
  p.zb1 = (u16*)big;
  p.zb2 = (u16*)(big + (100ull << 20));
  p.bar = (unsigned*)(ws + (250ull << 20));
  p.kic = (u16*)(ws + (233ull << 20)); p.kc = (u16*)(ws + (235ull << 20)); p.vc = (u16*)(ws + (238ull << 20));
  hipMemsetAsync(p.bar, 0, WQ_WORDS * 4, stream);

  static int grid_blocks = 0;
  if (!grid_blocks) {
    int dev = 0, cus = 0, per_cu = 0;
    hipGetDevice(&dev);
    hipDeviceGetAttribute(&cus, hipDeviceAttributeMultiprocessorCount, dev);
    hipOccupancyMaxActiveBlocksPerMultiprocessor(&per_cu, mega, 256, 0);
    if (per_cu > 2) per_cu = 2;
    if (per_cu < 1) per_cu = 1;
    grid_blocks = cus * per_cu;
  }
#if MULTI
  for (int ph = 0; ph < NPHASE; ++ph) {
    hipLaunchKernelGGL(mega, dim3(grid_blocks), dim3(256), 0, stream, p, ph, ph + 1, 1);
  }
#else
  int ph0 = 0, ph1 = NPHASE, dryflag = 1;
  void* args[] = {&p, &ph0, &ph1, &dryflag};
  hipError_t e = hipLaunchCooperativeKernel((void*)mega, dim3(grid_blocks), dim3(256), args, 0, stream);
  if (e != hipSuccess) fprintf(stderr, "cooperative launch failed: %s (grid %d)\n", hipGetErrorString(e), grid_blocks);
#endif
}
```
